# Optimizing an MI355X kernel written in HIP

```python
import math
import jax, jax.numpy as jnp
from jax import lax
import numpy as np

D_MODEL = 1024
BATCH = 16
SEQ = 2048
DEPTH = 4

HEAD_DIM = 64
SWA_Q_HEADS = 8
SWA_KV_HEADS = 2
SWA_GROUP = SWA_Q_HEADS // SWA_KV_HEADS
SWA_WINDOW = 128
SB_HEADS = 8
BLOCK = 128
N_EXPERTS = 32
N_GROUPS = 8
EXPERTS_PER_GROUP = N_EXPERTS // N_GROUPS
TOP_K = 2
D_EXPERT = 512
MOE_BLOCK = 128
LN_EPS = 1e-5
DEEPNORM_ALPHA = (2 * DEPTH) ** 0.25
DEEPNORM_BETA = (8 * DEPTH) ** -0.25
PROJ_SIZES = (SWA_Q_HEADS * HEAD_DIM, SWA_KV_HEADS * HEAD_DIM, SWA_KV_HEADS * HEAD_DIM,
              SB_HEADS * HEAD_DIM, SB_HEADS * HEAD_DIM, SB_HEADS * HEAD_DIM,
              D_MODEL, D_MODEL)
VALUE_SLOTS = (2, 5)

kernel_name = "hybrid_swa_stickbreak_groupmoe_deepnorm"


def layer_norm(x, g, b):
    xf = x.astype(jnp.float32)
    mu = xf.mean(-1, keepdims=True)
    var = jnp.square(xf - mu).mean(-1, keepdims=True)
    y = (xf - mu) * lax.rsqrt(var + LN_EPS) * g.astype(jnp.float32) + b.astype(jnp.float32)
    return y.astype(x.dtype)


def alibi_slopes(n_heads):
    return jnp.exp2(-8.0 * (jnp.arange(n_heads, dtype=jnp.float32) + 1.0) / n_heads)


def sliding_window_attention(q, k, v, sinks):
    B, S = q.shape[0], q.shape[1]
    nb = S // BLOCK
    qb = q.reshape(B, nb, BLOCK, SWA_KV_HEADS, SWA_GROUP, HEAD_DIM).astype(jnp.float32)

    def with_prev(t):
        tb = t.reshape(B, nb, BLOCK, SWA_KV_HEADS, HEAD_DIM)
        prev = jnp.pad(tb[:, :-1], ((0, 0), (1, 0), (0, 0), (0, 0), (0, 0)))
        return jnp.concatenate([prev, tb], axis=2).astype(jnp.float32)

    kb, vb = with_prev(k), with_prev(v)
    scores = jnp.einsum('bnqhgd,bnkhd->bnhgqk', qb, kb) * (HEAD_DIM ** -0.5)
    i = jnp.arange(BLOCK)[:, None]
    j = jnp.arange(2 * BLOCK)[None, :]
    dist = i + BLOCK - j
    blk = jnp.arange(nb)[:, None, None]
    valid = (dist >= 0) & (dist < SWA_WINDOW) & ((blk - 1) * BLOCK + j[None] >= 0)
    slopes = alibi_slopes(SWA_Q_HEADS).reshape(SWA_KV_HEADS, SWA_GROUP)
    scores = scores - slopes[:, :, None, None] * dist.astype(jnp.float32)
    scores = jnp.where(valid[None, :, None, None], scores, -jnp.inf)
    sink = sinks.astype(jnp.float32).reshape(SWA_KV_HEADS, SWA_GROUP)[:, :, None, None]
    m = jnp.maximum(scores.max(-1, keepdims=True), sink)
    p = jnp.exp(scores - m)
    probs = p / (p.sum(-1, keepdims=True) + jnp.exp(sink - m))
    out = jnp.einsum('bnhgqk,bnkhd->bnqhgd', probs, vb)
    return out.reshape(B, S, SWA_Q_HEADS * HEAD_DIM)


def stick_breaking_attention(q, k, v):
    B, S = q.shape[0], q.shape[1]
    qf, kf, vf = q.astype(jnp.float32), k.astype(jnp.float32), v.astype(jnp.float32)
    outs = []
    for t0 in range(0, S, BLOCK):
        n_keys = t0 + BLOCK
        z = jnp.einsum('bqhd,bkhd->bhqk', qf[:, t0:t0 + BLOCK], kf[:, :n_keys]) * (HEAD_DIM ** -0.5)
        strict = jnp.arange(n_keys)[None, :] < (t0 + jnp.arange(BLOCK))[:, None]
        log_keep = jnp.where(strict, jax.nn.log_sigmoid(-z), 0.0)
        between = lax.cumsum(log_keep, axis=3, reverse=True) - log_keep
        a = jnp.where(strict, jnp.exp(jax.nn.log_sigmoid(z) + between), 0.0)
        outs.append(jnp.einsum('bhqk,bkhd->bqhd', a, vf[:, :n_keys]))
    return jnp.concatenate(outs, axis=1).reshape(B, S, SB_HEADS * HEAD_DIM)


def token_mixer(x, w_in, b_in, sinks, w_branch_a, w_branch_b, w_out):
    B, S, _ = x.shape
    proj = jnp.einsum('bsd,dn->bsn', x, w_in) + b_in
    cuts, acc = [], 0
    for n in PROJ_SIZES[:-1]:
        acc += n
        cuts.append(acc)
    a_q, a_k, a_v, s_q, s_k, s_v, g_a, g_b = jnp.split(proj, cuts, axis=-1)
    y_a = sliding_window_attention(a_q.reshape(B, S, SWA_Q_HEADS, HEAD_DIM),
                                   a_k.reshape(B, S, SWA_KV_HEADS, HEAD_DIM),
                                   a_v.reshape(B, S, SWA_KV_HEADS, HEAD_DIM), sinks).astype(x.dtype)
    y_b = stick_breaking_attention(s_q.reshape(B, S, SB_HEADS, HEAD_DIM),
                                   s_k.reshape(B, S, SB_HEADS, HEAD_DIM),
                                   s_v.reshape(B, S, SB_HEADS, HEAD_DIM)).astype(x.dtype)
    merged = (jax.nn.sigmoid(g_a) * jnp.einsum('bsc,cd->bsd', y_a, w_branch_a)
              + jax.nn.sigmoid(g_b) * jnp.einsum('bsc,cd->bsd', y_b, w_branch_b))
    return jnp.einsum('bsd,de->bse', merged, w_out)


def group_route(x2d, w_router, router_bias):
    T = x2d.shape[0]
    aff = jax.nn.sigmoid(x2d.astype(jnp.float32) @ w_router.astype(jnp.float32))
    biased = (aff + router_bias.astype(jnp.float32)).reshape(T, N_GROUPS, EXPERTS_PER_GROUP)
    group_score = lax.top_k(biased, TOP_K)[0].sum(-1)
    g_sel = jnp.argmax(group_score, axis=-1)
    in_group = jnp.take_along_axis(biased, g_sel[:, None, None], axis=1)[:, 0]
    _, local = lax.top_k(in_group, TOP_K)
    idx = g_sel[:, None] * EXPERTS_PER_GROUP + local
    w = jnp.take_along_axis(aff, idx, axis=1)
    return idx, w / w.sum(-1, keepdims=True)


def moe(x, w_router, router_bias, w_gate, w_up, w_down):
    B, S, D = x.shape
    T = B * S
    x2d = x.reshape(T, D)
    idx, gates = group_route(x2d, w_router, router_bias)
    flat_e = idx.reshape(-1)
    flat_tok = jnp.repeat(jnp.arange(T, dtype=jnp.int32), TOP_K)
    flat_gate = gates.reshape(-1)
    order = jnp.argsort(flat_e)
    sorted_e = flat_e[order]
    counts = jnp.zeros((N_EXPERTS,), jnp.int32).at[flat_e].add(1)
    padded = ((counts + MOE_BLOCK - 1) // MOE_BLOCK) * MOE_BLOCK
    pad_end = jnp.cumsum(padded)
    pad_start = pad_end - padded
    start = jnp.cumsum(counts) - counts
    rank = jnp.arange(T * TOP_K) - start[sorted_e]
    dest = pad_start[sorted_e] + rank
    n_blocks = -(-(T * TOP_K) // MOE_BLOCK) + N_EXPERTS
    P = n_blocks * MOE_BLOCK
    buf_tok = jnp.full((P,), T, jnp.int32).at[dest].set(flat_tok[order])
    buf_gate = jnp.zeros((P,), jnp.float32).at[dest].set(flat_gate[order])
    block_expert = jnp.minimum(
        jnp.searchsorted(pad_end, jnp.arange(n_blocks) * MOE_BLOCK, side='right'), N_EXPERTS - 1)
    xpad = jnp.concatenate([x2d, jnp.zeros((1, D), x2d.dtype)], axis=0)
    xblocks = xpad[buf_tok].reshape(n_blocks, MOE_BLOCK, D)

    def expert_block(args):
        xb, e = args
        h = jax.nn.silu(xb @ w_gate[e]) * (xb @ w_up[e])
        return h @ w_down[e]

    yb = lax.map(expert_block, (xblocks, block_expert)).reshape(P, D)
    y = jax.ops.segment_sum(yb.astype(jnp.float32) * buf_gate[:, None], buf_tok, num_segments=T + 1)[:T]
    return y.astype(x.dtype).reshape(B, S, D)


def setup_inputs(seed: int = 0) -> dict:
    key = jax.random.key(seed)
    ks = jax.random.split(key, 16)
    n_in = sum(PROJ_SIZES)
    col_scale = jnp.concatenate([
        jnp.full((n,), DEEPNORM_BETA if i in VALUE_SLOTS else 1.0, jnp.float32)
        for i, n in enumerate(PROJ_SIZES)])
    d_a = SWA_Q_HEADS * HEAD_DIM
    d_b = SB_HEADS * HEAD_DIM
    nrm = lambda k, shape: jax.random.normal(k, shape, jnp.float32)
    return {
        "x": nrm(ks[0], (BATCH, SEQ, D_MODEL)),
        "w_in": nrm(ks[1], (DEPTH, D_MODEL, n_in)) * (D_MODEL ** -0.5) * col_scale,
        "b_in": 0.02 * nrm(ks[2], (DEPTH, n_in)),
        "attn_sinks": nrm(ks[3], (DEPTH, SWA_Q_HEADS)),
        "w_branch_a": nrm(ks[4], (DEPTH, d_a, D_MODEL)) * (d_a ** -0.5) * DEEPNORM_BETA,
        "w_branch_b": nrm(ks[5], (DEPTH, d_b, D_MODEL)) * (d_b ** -0.5) * DEEPNORM_BETA,
        "w_out": nrm(ks[6], (DEPTH, D_MODEL, D_MODEL)) * (D_MODEL ** -0.5) * DEEPNORM_BETA,
        "ln1_g": 1.0 + 0.02 * nrm(ks[7], (DEPTH, D_MODEL)),
        "ln1_b": 0.02 * nrm(ks[8], (DEPTH, D_MODEL)),
        "w_router": nrm(ks[9], (D_MODEL, N_EXPERTS)) * (D_MODEL ** -0.5),
        "router_bias": 0.01 * nrm(ks[10], (N_EXPERTS,)),
        "w_gate": nrm(ks[11], (DEPTH, N_EXPERTS, D_MODEL, D_EXPERT)) * (D_MODEL ** -0.5),
        "w_up": nrm(ks[12], (DEPTH, N_EXPERTS, D_MODEL, D_EXPERT)) * (D_MODEL ** -0.5) * DEEPNORM_BETA,
        "w_down": nrm(ks[13], (DEPTH, N_EXPERTS, D_EXPERT, D_MODEL)) * (D_EXPERT ** -0.5) * DEEPNORM_BETA,
        "ln2_g": 1.0 + 0.02 * nrm(ks[14], (DEPTH, D_MODEL)),
        "ln2_b": 0.02 * nrm(ks[15], (DEPTH, D_MODEL)),
    }


def reference(x, w_in, b_in, attn_sinks, w_branch_a, w_branch_b, w_out, ln1_g, ln1_b,
              w_router, router_bias, w_gate, w_up, w_down, ln2_g, ln2_b):
    for l in range(DEPTH):
        mix = token_mixer(x, w_in[l], b_in[l], attn_sinks[l], w_branch_a[l], w_branch_b[l], w_out[l])
        x = layer_norm(DEEPNORM_ALPHA * x + mix, ln1_g[l], ln1_b[l])
        ffn = moe(x, w_router, router_bias, w_gate[l], w_up[l], w_down[l])
        x = layer_norm(DEEPNORM_ALPHA * x + ffn, ln2_g[l], ln2_b[l])
    return x
```

```cpp
#include <hip/hip_runtime.h>
#include <cstdio>
#include <cstdint>

#ifndef MK_ONE_LAUNCH
#define MK_ONE_LAUNCH 1
#endif
#ifndef DIAG
#define DIAG 0
#define REP_MASK 0x000
#define NREP(p) (((REP_MASK >> (p)) & 1) ? 2 : 1)
#endif

#define LAS __attribute__((address_space(3)))
#define GAS __attribute__((address_space(1)))
typedef unsigned short bf16_t;
typedef short bf16x8 __attribute__((ext_vector_type(8)));
typedef float f32x4 __attribute__((ext_vector_type(4)));
typedef float f32x2 __attribute__((ext_vector_type(2)));
typedef unsigned u32x4 __attribute__((ext_vector_type(4)));
typedef unsigned u32x2 __attribute__((ext_vector_type(2)));
typedef GAS unsigned gu32;

constexpr int D = 1024, BATCH = 16, SEQ = 2048, T = BATCH * SEQ, DEPTH = 4;
constexpr int NIN = 4352, NE = 32, DE = 512;
constexpr int PP = 2304;
constexpr int C_AQ = 0, C_AK = 512, C_AV = 640, C_SQ = 768, C_SK = 1280, C_SV = 1792, C_GA = 2304, C_GB = 3328;
constexpr float LN_EPS = 1e-5f;
constexpr float ALPHA = 1.6817928305074290f;
constexpr float LOG2E = 1.4426950408889634f;
constexpr float C2 = 0.125f * LOG2E;
constexpr int TOKCAP = T;
constexpr int MAXTILES = T * 2 / 256 + NE;

constexpr size_t MiB = 1u << 20;
constexpr size_t WS_CTL = 0, CTL_ZERO_BYTES = 1 * MiB;
constexpr size_t WS_BIAS = 1 * MiB;
constexpr size_t WS_WIN = 2 * MiB;
constexpr size_t WS_WA = 36 * MiB, WS_WB = 40 * MiB;
constexpr size_t WS_WO = 44 * MiB;
constexpr size_t WS_WGU = 52 * MiB;
constexpr size_t WS_WD = 308 * MiB;
constexpr size_t WS_XB = 436 * MiB;
constexpr size_t WS_PROJ = 500 * MiB;
constexpr size_t WS_GATE = 644 * MiB;
constexpr size_t WS_H = 500 * MiB;
constexpr size_t WS_Y2 = 906 * MiB;
constexpr size_t WS_YA = 772 * MiB, WS_YB = 804 * MiB;
constexpr size_t WS_MIX = 180 * MiB;
constexpr size_t WS_MERGED = 836 * MiB;
constexpr size_t WS_XF8 = WS_MERGED + 32 * MiB;
constexpr float SMX8 = 32.f;
constexpr float SX8 = 8.f, SW8 = 64.f, SY8 = 64.f, SM8 = 128.f, SH8 = 16.f, SG8 = 256.f, SY28 = 128.f;
constexpr int E_X8 = 0x01010101 * (127 - 3), E_W8 = 0x01010101 * (127 - 6), E_Y8 = 0x01010101 * (127 - 6), E_M8 = 0x01010101 * (127 - 7), E_H8 = 0x01010101 * (127 - 4);
constexpr size_t WS_TOK = 900 * MiB;
constexpr size_t WS_SLOT = 904 * MiB;
constexpr size_t WS_END = 978 * MiB;
static_assert(WS_WIN + (size_t)DEPTH * NIN * D * 2 <= WS_WA && WS_WGU + (size_t)DEPTH * NE * 1024 * D * 2 <= WS_WD && WS_WD + (size_t)DEPTH * NE * D * 512 * 2 <= WS_XB, "ws map");
static_assert(WS_Y2 + (size_t)MAXTILES * 256 * D <= WS_END && WS_PROJ + (size_t)T * PP * 2 <= WS_GATE && WS_GATE + (size_t)2 * T * D * 2 <= WS_YA && WS_H + (size_t)MAXTILES * 256 * 512 * 2 <= WS_Y2 && WS_WGU + (size_t)DEPTH * NE * 1024 * D <= WS_MIX && WS_MIX + (size_t)T * D * 2 <= WS_WD && WS_H + (size_t)MAXTILES * 256 * 512 <= WS_GATE, "ws map 2");
constexpr int CW_CLS = 8192;
constexpr int CW_TMO = 0, CW_CODE = 1, CW_BAR = 4096, CW_CNT = 16384;

constexpr int RING_BYTES = 131072;
constexpr int LC_OFF = 132096;
constexpr int LC_MISC = LC_OFF + 0;
constexpr int LC_HIST = LC_OFF + 256, LC_BASE = LC_OFF + 384, LC_CNT = LC_OFF + 512, LC_TSTART = LC_OFF + 704;
constexpr int LC_T2E = LC_OFF + 1024;
constexpr int LC_SE = LC_OFF + 2560, LC_SR = LC_SE + 1024, LC_SG = LC_SR + 1024;
constexpr int LC_LOGIT = LC_OFF + 5632;
constexpr int LC_GB = LC_OFF + 22528;
constexpr int LC_RB = LC_GB + 8192;
constexpr int LDS_BYTES = LC_RB + 128;
static_assert(LC_SG + 1024 <= LC_LOGIT && LC_LOGIT + 128 * 33 * 4 <= LC_GB && LDS_BYTES <= 160 * 1024 && LC_T2E + MAXTILES * 4 <= LC_SE && 32 * 1028 * 4 <= LC_OFF, "LDS map");

constexpr int NWAVES = 8, NTHREADS = 512;

__device__ __forceinline__ unsigned cvt_pk_bf16(float lo, float hi) { unsigned r; asm volatile("v_cvt_pk_bf16_f32 %0, %1, %2" : "=v"(r) : "v"(lo), "v"(hi)); return r; }
__device__ __forceinline__ float bf_lo(unsigned u) { return __uint_as_float(u << 16); }
__device__ __forceinline__ float bf_hi(unsigned u) { return __uint_as_float(u & 0xffff0000u); }
__device__ __forceinline__ int lane_now() { int l_; asm volatile("v_mbcnt_lo_u32_b32 %0, -1, 0\n\tv_mbcnt_hi_u32_b32 %0, -1, %0" : "=v"(l_)); return l_; }
__device__ __forceinline__ unsigned pk4_fp8(float a, float b, float c, float d) {
    int w = __builtin_amdgcn_cvt_pk_fp8_f32(a, b, 0, false); w = __builtin_amdgcn_cvt_pk_fp8_f32(c, d, w, true); return (unsigned)w; }
__device__ __forceinline__ float wave_sum(float x) {
    x += __int_as_float(__builtin_amdgcn_update_dpp(0, __float_as_int(x), 0xB1, 0xf, 0xf, false));
    x += __int_as_float(__builtin_amdgcn_update_dpp(0, __float_as_int(x), 0x4E, 0xf, 0xf, false));
    x += __int_as_float(__builtin_amdgcn_update_dpp(0, __float_as_int(x), 0x141, 0xf, 0xf, false));
    x += __int_as_float(__builtin_amdgcn_update_dpp(0, __float_as_int(x), 0x140, 0xf, 0xf, false));
    { const unsigned u = __float_as_uint(x); auto r = __builtin_amdgcn_permlane16_swap(u, u, false, false); x = __uint_as_float(r[0]) + __uint_as_float(r[1]); }
    { const unsigned u = __float_as_uint(x); auto r = __builtin_amdgcn_permlane32_swap(u, u, false, false); x = __uint_as_float(r[0]) + __uint_as_float(r[1]); }
    return x;
}
__device__ __forceinline__ float shx(float v, int o, int lane) { return __int_as_float(__builtin_amdgcn_ds_bpermute((lane ^ o) << 2, __float_as_int(v))); }
__device__ __forceinline__ float fast_exp2(float x) { return __builtin_amdgcn_exp2f(x); }
__device__ __forceinline__ float fast_rcp(float x) { return __builtin_amdgcn_rcpf(x); }
__device__ __forceinline__ float sigmoidf_(float x) { return 1.0f / (1.0f + __expf(-x)); }

#define XB_TMO      128
#define XB_XCNT(j)  (256  + 64 * (j))
#define XB_XSUB(j)  (1280 + 64 * (j))
#define XB_XGEN(j)  (2304 + 64 * (j))
#define XB_XLOC(j)  (4160 + 64 * (j))
#define XB_TOP      3328
#define XB_TOPGEN   3392
#define XCD_BAR_WORDS 3456
#define XB_SPIN_CAP (1u << 18)
__device__ __forceinline__ unsigned xb_ld(unsigned* p)              { return __hip_atomic_load(p, __ATOMIC_RELAXED, __HIP_MEMORY_SCOPE_AGENT); }
__device__ __forceinline__ unsigned xb_add(unsigned* p, unsigned v) { return __hip_atomic_fetch_add(p, v, __ATOMIC_RELAXED, __HIP_MEMORY_SCOPE_AGENT); }
__device__ __forceinline__ unsigned xb_xcc_id() { return (unsigned)__builtin_amdgcn_s_getreg((3 << 11) | 20) & 0xFu; }
#define XB_SPIN(cond, bar) do { unsigned _sp = 0; while (cond) { __builtin_amdgcn_s_sleep(1); \
    if ((++_sp & 255u) == 0u) { if (xb_ld(&(bar)[XB_TMO])) break; if (_sp > XB_SPIN_CAP) { atomicAdd(&(bar)[XB_TMO], 1u); break; } } } } while (0)
struct XcdBarrier { unsigned* bar; unsigned x; volatile LAS unsigned* st; };
__device__ __forceinline__ XcdBarrier xcd_barrier_post(unsigned* bar, volatile LAS unsigned* st) {
    XcdBarrier b; b.bar = bar; b.x = xb_xcc_id(); b.st = st;
    if (threadIdx.x == 0) (void)xb_add(&bar[XB_XCNT(b.x)], 1u);
    return b;
}
__device__ __forceinline__ void xcd_barrier_complete(unsigned* bar, unsigned x, unsigned& nloc, unsigned& nx) {
    const unsigned G = gridDim.x * gridDim.y * gridDim.z;
    unsigned sum, cnt, mine, sp = 0u;
    for (;;) {
        sum = 0u; cnt = 0u; mine = 0u;
#pragma unroll
        for (unsigned j = 0; j < 16; ++j) { const unsigned c = xb_ld(&bar[XB_XCNT(j)]); sum += c; cnt += (c > 0u) ? 1u : 0u; mine = (j == x) ? c : mine; }
        if (sum == G) break;
        __builtin_amdgcn_s_sleep(1);
        if ((++sp & 255u) == 0u) { if (xb_ld(&bar[XB_TMO])) break; if (sp > XB_SPIN_CAP) { atomicAdd(&bar[XB_TMO], 1u); break; } }
    }
    nloc = mine > 0u ? mine : 1u; nx = cnt > 0u ? cnt : 1u;
}
__device__ __forceinline__ void xcd_barrier(const XcdBarrier& b) {
    asm volatile("s_waitcnt vmcnt(0)" ::: "memory");
    __syncthreads();
    if (threadIdx.x == 0) {
        unsigned* bar = b.bar;
        __builtin_amdgcn_s_waitcnt(0);
        unsigned nloc = b.st[0], nx = b.st[1];
        if (nloc == 0u) { xcd_barrier_complete(bar, b.x, nloc, nx); b.st[0] = nloc; b.st[1] = nx; }
        const unsigned old = xb_add(&bar[XB_XSUB(b.x)], 1u);
        const unsigned gen = old / nloc;
        if (old + 1u == (gen + 1u) * nloc) {
            __builtin_amdgcn_fence(__ATOMIC_RELEASE, "agent");
            asm volatile("s_waitcnt vmcnt(0)" ::: "memory");
            const unsigned og = xb_add(&bar[XB_TOP], 1u);
            const unsigned tg = og / nx;
            if (og + 1u == (tg + 1u) * nx) xb_add(&bar[XB_TOPGEN], 1u);
            else XB_SPIN(xb_ld(&bar[XB_TOPGEN]) == tg, bar);
            __builtin_amdgcn_fence(__ATOMIC_ACQUIRE, "agent");
            xb_add(&bar[XB_XGEN(b.x)], 1u);
            asm volatile("s_waitcnt vmcnt(0)" ::: "memory");
        } else {
            XB_SPIN(xb_ld(&bar[XB_XGEN(b.x)]) == gen, bar);
            __builtin_amdgcn_fence(__ATOMIC_ACQUIRE, "agent");
            asm volatile("s_waitcnt vmcnt(0)" ::: "memory");
        }
    }
    __syncthreads();
}

namespace pg8 {
constexpr int BM = 256, BK = 64, HALF = 128, HTB = HALF * BK * 2, STAGE_BYTES = 8 * HTB, NXCD = 8, WGM = 8;
__host__ __device__ __forceinline__ int lds_byte(int r, int c) { const int st = (r >> 4) * 2 + (c >> 5), rr = r & 15, cc = c & 31, ob = rr * 64 + cc * 2; return st * 1024 + (ob ^ (((ob >> 9) & 1) << 5)); }
__host__ __device__ __forceinline__ void stage_rc(int b, int& R, int& C) { const int st = b / 1024, sb = b % 1024, swz = sb ^ (((sb >> 9) & 1) << 5); R = (st >> 1) * 16 + swz / 64; C = (st & 1) * 32 + (swz % 64) / 2; }
__host__ __device__ __forceinline__ int perm32(int rho) { const int n = rho >> 4, i = rho & 15; return 8 * (i >> 2) + 4 * n + (i & 3); }

struct Unit { int pm, pn, aux; };

__device__ __forceinline__ bool static_tile(int nM, int nN, int G, int c, int i, int& pm, int& pn) {
    const int nwg = nM * nN; const long L = (long)i * G + c; if (L >= nwg) return false;
    int wgid = (int)L; { const int q = nwg / NXCD, r = nwg % NXCD, xcd = wgid % NXCD, off = wgid / NXCD; wgid = (xcd < r ? xcd * (q + 1) : r * (q + 1) + (xcd - r) * q) + off; }
    const int nig = WGM * nN, gid = wgid / nig, fm = gid * WGM, gsz = (nM - fm) < WGM ? (nM - fm) : WGM;
    pm = fm + ((wgid % nig) % gsz); pn = (wgid % nig) / gsz; return true;
}

template <int K, bool GATHER, class Epi, class Sched, bool TWOSEG = false, bool FP8 = false>
__device__ __forceinline__ void gemm_phase(LAS unsigned char* lds, const int tid, const Sched& S, const Epi& E, const int sc_a = 0x7f7f7f7f, const int sc_b = 0x7f7f7f7f) {
    const int wid = __builtin_amdgcn_readfirstlane(tid >> 6), lane = tid & 63, wr = wid >> 2, wc = wid & 3, fr = lane & 15, fq = lane >> 4;
    constexpr int nt = K / BK;
    constexpr int LD = TWOSEG ? K / 2 : K;
    static_assert(K % 128 == 0 && K >= 256 && (!TWOSEG || (nt % 4 == 0 && !GATHER)), "K");
    int Rr[2], Cc[2]; unsigned voffB[2];
#pragma unroll
    for (int i = 0; i < 2; ++i) { int R, C; stage_rc(tid * 16 + i * 8192, R, C); const int Rb = (R & ~31) + perm32(R & 31); Rr[i] = R; Cc[i] = C; voffB[i] = (unsigned)(Rb * LD + C) * 2u; }
    constexpr size_t kstep = (size_t)(BK * 2);
    constexpr size_t hstepB = (size_t)HALF * LD * 2;
    constexpr size_t hstepA = GATHER ? 0 : (size_t)HALF * LD * 2;
    const unsigned ldsw = (unsigned)wid * 1024u; const unsigned ldsbase = (unsigned)(uintptr_t)lds;
    const int aoff = lds_byte(wr * 64 + fr, fq * 8), boff = lds_byte(wc * 32 + fr, fq * 8);
#define PG8_SA(b, h) (((b) * 2 + (h)) * HTB)
#define PG8_SB(b, h) ((4 + (b) * 2 + (h)) * HTB)
#define PG8_STAGE(bufoff, gbase, voff) do { _Pragma("unroll") for (int _i = 0; _i < 2; ++_i) { \
        if constexpr (FP8 || GATHER) { unsigned keep_; asm volatile("s_mov_b32 %0, m0\n\ts_mov_b32 m0, %3\n\ts_nop 0\n\tglobal_load_lds_dwordx4 %1, %2\n\ts_mov_b32 m0, %0" : "=&s"(keep_) : "v"((voff)[_i]), "s"((const char*)(gbase)), \
                     "s"((unsigned)__builtin_amdgcn_readfirstlane((int)(ldsbase + (unsigned)(bufoff) + ldsw + _i * 8192u))) : "memory"); } \
        else __builtin_amdgcn_global_load_lds((const unsigned*)((const char*)(gbase) + (voff)[_i]), (LAS unsigned*)(lds + (bufoff) + ldsw + _i * 8192), 16, 0, 0); } } while (0)
    typedef int v8i_ __attribute__((ext_vector_type(8))); typedef int v4i_ __attribute__((ext_vector_type(4)));
#define PG8_LDA(dst, b, h) do { _Pragma("unroll") for (int m = 0; m < 4; ++m) { \
        if constexpr (FP8) { const v4i_ lo_ = *(const LAS v4i_*)(lds + PG8_SA(b, h) + aoff + m * 2048), hi_ = *(const LAS v4i_*)(lds + PG8_SA(b, h) + aoff + m * 2048 + 1024); dst##8[m] = __builtin_shufflevector(lo_, hi_, 0, 1, 2, 3, 4, 5, 6, 7); } \
        else { _Pragma("unroll") for (int k = 0; k < 2; ++k) dst[m][k] = *(const LAS bf16x8*)(lds + PG8_SA(b, h) + aoff + m * 2048 + k * 1024); } } } while (0)
#define PG8_LDB(dst, b, h) do { _Pragma("unroll") for (int n = 0; n < 2; ++n) { \
        if constexpr (FP8) { const v4i_ lo_ = *(const LAS v4i_*)(lds + PG8_SB(b, h) + boff + n * 2048), hi_ = *(const LAS v4i_*)(lds + PG8_SB(b, h) + boff + n * 2048 + 1024); dst##8[n] = __builtin_shufflevector(lo_, hi_, 0, 1, 2, 3, 4, 5, 6, 7); } \
        else { _Pragma("unroll") for (int k = 0; k < 2; ++k) dst[n][k] = *(const LAS bf16x8*)(lds + PG8_SB(b, h) + boff + n * 2048 + k * 1024); } } } while (0)
#define PG8_MMA(ai, bj, At, Bt) do { __builtin_amdgcn_s_setprio(1); _Pragma("unroll") for (int m = 0; m < 4; ++m) _Pragma("unroll") for (int n = 0; n < 2; ++n) { \
        if constexpr (FP8) acc[ai][bj][m][n] = __builtin_amdgcn_mfma_scale_f32_16x16x128_f8f6f4(Bt##8[n], At##8[m], acc[ai][bj][m][n], 0, 0, 0, sc_b, 0, sc_a); \
        else { _Pragma("unroll") for (int k = 0; k < 2; ++k) acc[ai][bj][m][n] = __builtin_amdgcn_mfma_f32_16x16x32_bf16(Bt[n][k], At[m][k], acc[ai][bj][m][n], 0, 0, 0); } } \
        __builtin_amdgcn_s_setprio(0); } while (0)
#define PG8_WAIT_V(n) asm volatile("s_waitcnt vmcnt(" #n ")" ::: "memory")
#define PG8_WAIT_L(n) asm volatile("s_waitcnt lgkmcnt(" #n ")" ::: "memory")
#define PG8_BAR __builtin_amdgcn_s_barrier()
#define PG8_SCHED __builtin_amdgcn_sched_barrier(0)
    Unit cur, nxt; int ui = 0;
    if (!S.next(0, cur)) return;
    unsigned voffA[2][2], nvoffA[2][2];
    if constexpr (GATHER) {
        S.gather_issue(cur, Rr, voffA);
        asm volatile("s_waitcnt vmcnt(0)" : "+v"(voffA[0][0]), "+v"(voffA[0][1]), "+v"(voffA[1][0]), "+v"(voffA[1][1]) :: "memory");
#pragma unroll
        for (int h = 0; h < 2; ++h)
#pragma unroll
            for (int i = 0; i < 2; ++i) voffA[h][i] = S.gather_finish(voffA[h][i], Cc[i]);
    }
    else {
#pragma unroll
        for (int h = 0; h < 2; ++h)
#pragma unroll
            for (int i = 0; i < 2; ++i) voffA[h][i] = (unsigned)(Rr[i] * LD + Cc[i]) * 2u;
    }
    f32x4 acc[2][2][4][2];
#pragma unroll
    for (int a = 0; a < 2; ++a)
#pragma unroll
        for (int b = 0; b < 2; ++b)
#pragma unroll
            for (int m = 0; m < 4; ++m)
#pragma unroll
                for (int n = 0; n < 2; ++n) { f32x4 z_; asm volatile("v_mov_b32 %0, 0\n\tv_mov_b32 %1, 0\n\tv_mov_b32 %2, 0\n\tv_mov_b32 %3, 0" : "=v"(z_[0]), "=v"(z_[1]), "=v"(z_[2]), "=v"(z_[3])); acc[a][b][m][n] = z_; }
    const char* cA = S.abase(cur); const char* cB = S.bbase(cur);
    PG8_STAGE(PG8_SB(0, 0), cB, voffB); PG8_STAGE(PG8_SB(0, 1), cB + hstepB, voffB); PG8_STAGE(PG8_SA(0, 0), cA, voffA[0]); PG8_STAGE(PG8_SA(0, 1), cA + hstepA, voffA[1]);
    if (wr == 1) PG8_BAR;
    PG8_WAIT_V(2); PG8_BAR;
    PG8_STAGE(PG8_SB(1, 0), cB + kstep, voffB); PG8_STAGE(PG8_SA(1, 0), cA + kstep, voffA[0]); PG8_STAGE(PG8_SB(1, 1), cB + hstepB + kstep, voffB);
    PG8_WAIT_V(6); PG8_BAR;
    for (;;) {
        const bool has_next = S.next(ui + 1, nxt);
        const char* nA = has_next ? S.abase(nxt) : cA; const char* nB = has_next ? S.bbase(nxt) : cB;
        if constexpr (GATHER) {
            if (has_next) S.gather_issue(nxt, Rr, nvoffA);
        }
#pragma unroll 1
        for (int t = 0; t < nt; t += 2) {
            const bool last = (t == nt - 2);
            bf16x8 At[4][2], B0[2][2], B1[2][2]; v8i_ At8[4], B08[2], B18[2];
            (void)At; (void)B0; (void)B1; (void)At8; (void)B08; (void)B18;
            long sA1 = 0, sA2 = 0, sB2 = 0;
            if constexpr (TWOSEG) { if (t + 1 >= nt / 2) sA1 = S.adiff - (long)(nt / 2) * (long)kstep; if (t + 2 >= nt / 2) { sA2 = S.adiff - (long)(nt / 2) * (long)kstep; sB2 = S.bdiff - (long)(nt / 2) * (long)kstep; } }
            const char* a1 = cA + (size_t)(t + 1) * kstep + sA1;
            const char* a2 = last ? nA : cA + (size_t)(t + 2) * kstep + sA2; const char* b2 = last ? nB : cB + (size_t)(t + 2) * kstep + sB2;
            const char* a3 = a2 + kstep; const char* b3 = b2 + kstep;
            PG8_LDB(B0, 0, 0); PG8_LDB(B1, 0, 1); PG8_SCHED; PG8_LDA(At, 0, 0); PG8_STAGE(PG8_SA(1, 1), a1 + hstepA, voffA[1]);
            if constexpr (GATHER) { if (last) {
#pragma unroll
                for (int h = 0; h < 2; ++h)
#pragma unroll
                    for (int i = 0; i < 2; ++i) { if (has_next) voffA[h][i] = S.gather_finish(nvoffA[h][i], Cc[i]); }
            } }
            PG8_WAIT_V(8); PG8_WAIT_L(0); PG8_BAR; PG8_MMA(0, 0, At, B0); PG8_MMA(0, 1, At, B1); PG8_BAR; PG8_SCHED;
            PG8_LDA(At, 0, 1); PG8_STAGE(PG8_SB(0, 0), b2, voffB); PG8_STAGE(PG8_SB(0, 1), b2 + hstepB, voffB); PG8_STAGE(PG8_SA(0, 0), a2, voffA[0]);
            PG8_WAIT_V(8); PG8_WAIT_L(0); PG8_BAR; PG8_MMA(1, 0, At, B0); PG8_MMA(1, 1, At, B1); PG8_BAR; PG8_SCHED;
            PG8_LDB(B0, 1, 0); PG8_LDB(B1, 1, 1); PG8_SCHED; PG8_LDA(At, 1, 0); PG8_STAGE(PG8_SA(0, 1), a2 + hstepA, voffA[1]);
            PG8_WAIT_V(8); PG8_WAIT_L(0); PG8_BAR; PG8_MMA(0, 0, At, B0); PG8_MMA(0, 1, At, B1); PG8_BAR; PG8_SCHED;
            PG8_LDA(At, 1, 1); PG8_STAGE(PG8_SB(1, 0), b3, voffB); PG8_STAGE(PG8_SB(1, 1), b3 + hstepB, voffB); PG8_STAGE(PG8_SA(1, 0), a3, voffA[0]);
            PG8_WAIT_V(8); PG8_WAIT_L(0); PG8_BAR; PG8_MMA(1, 0, At, B0); PG8_MMA(1, 1, At, B1); PG8_BAR; PG8_SCHED;
            if constexpr (TWOSEG) { if (t == nt / 2 - 2) { const int l2_ = lane_now(); E.mid(acc, cur, wr, wc, l2_ & 15, l2_ >> 4); } }
        }
        if (wr == 0) PG8_BAR;
        { const int l2_ = lane_now(); E(acc, cur, wr, wc, l2_ & 15, l2_ >> 4); }
        if (!has_next) break;
#pragma unroll
        for (int a = 0; a < 2; ++a)
#pragma unroll
            for (int b = 0; b < 2; ++b)
#pragma unroll
                for (int m = 0; m < 4; ++m)
#pragma unroll
                    for (int n = 0; n < 2; ++n) { f32x4 z_; asm volatile("v_mov_b32 %0, 0\n\tv_mov_b32 %1, 0\n\tv_mov_b32 %2, 0\n\tv_mov_b32 %3, 0" : "=v"(z_[0]), "=v"(z_[1]), "=v"(z_[2]), "=v"(z_[3])); acc[a][b][m][n] = z_; }
        cur = nxt; cA = nA; cB = nB; ++ui;
        if (wr == 1) PG8_BAR;
    }
    PG8_WAIT_V(0);
    PG8_BAR;
#undef PG8_SA
#undef PG8_SB
#undef PG8_STAGE
#undef PG8_LDA
#undef PG8_LDB
#undef PG8_MMA
#undef PG8_WAIT_V
#undef PG8_WAIT_L
#undef PG8_BAR
#undef PG8_SCHED
}

struct EpiProj {
    bf16_t* O; const float* bias; int nostore; unsigned char* G;
    __device__ __forceinline__ void operator()(const f32x4 (&acc)[2][2][4][2], const Unit& u, int wr, int wc, int fr, int fq) const {
        if (nostore) return;
        const int row0 = u.pm * BM + wr * 64 + fr, col0 = u.pn * BM + wc * 32 + 8 * fq;
        const bool sig = (u.pn * BM >= C_GA);
        const int gt = sig ? u.pn - C_GA / BM : 0;
        int lo_ = ((wr * 4 + wc) * 64 + fq * 16 + fr) * 8; asm volatile("" : "+v"(lo_));
        unsigned char* gbase = G + ((size_t)((gt >> 2) * (T / BM) + u.pm) * 4 + (gt & 3)) * (BM * BM) + (size_t)lo_;
        f32x4 bz0[2], bz1[2];
#pragma unroll
        for (int bj = 0; bj < 2; ++bj) { bz0[bj] = *(const f32x4*)(bias + col0 + bj * HALF); bz1[bj] = *(const f32x4*)(bias + col0 + bj * HALF + 4); }
#pragma unroll
        for (int ai = 0; ai < 2; ++ai)
#pragma unroll
            for (int m = 0; m < 4; ++m) { bf16_t* rowp = O + (size_t)(row0 + ai * HALF + m * 16) * PP + col0;
#pragma unroll
                for (int bj = 0; bj < 2; ++bj) { f32x4 v0 = acc[ai][bj][m][0] + bz0[bj], v1 = acc[ai][bj][m][1] + bz1[bj];
                    if (sig) {
#pragma unroll
                        for (int q = 0; q < 4; ++q) { v0[q] = fast_rcp(1.0f + fast_exp2(-LOG2E * v0[q])); v1[q] = fast_rcp(1.0f + fast_exp2(-LOG2E * v1[q])); }
                    }
                    if (sig) { u32x2 w8; w8.x = pk4_fp8(v0[0] * SG8, v0[1] * SG8, v0[2] * SG8, v0[3] * SG8); w8.y = pk4_fp8(v1[0] * SG8, v1[1] * SG8, v1[2] * SG8, v1[3] * SG8); *(u32x2*)(gbase + (size_t)(((ai * 4 + m) * 2 + bj) * 4096)) = w8; }
                    else { u32x4 w; w.x = cvt_pk_bf16(v0[0], v0[1]); w.y = cvt_pk_bf16(v0[2], v0[3]); w.z = cvt_pk_bf16(v1[0], v1[1]); w.w = cvt_pk_bf16(v1[2], v1[3]); *(u32x4*)(rowp + bj * HALF) = w; } }  asm volatile("" ::: "memory"); }
    }
};
struct EpiPlain {
    bf16_t* O; int ldc;
    __device__ __forceinline__ void operator()(const f32x4 (&acc)[2][2][4][2], const Unit& u, int wr, int wc, int fr, int fq) const {
        const int row0 = u.pm * BM + wr * 64 + fr, col0 = u.pn * BM + wc * 32 + 8 * fq;
#pragma unroll
        for (int ai = 0; ai < 2; ++ai)
#pragma unroll
            for (int m = 0; m < 4; ++m) { bf16_t* rowp = O + (size_t)(row0 + ai * HALF + m * 16) * ldc + col0;
#pragma unroll
                for (int bj = 0; bj < 2; ++bj) { const f32x4 v0 = acc[ai][bj][m][0], v1 = acc[ai][bj][m][1];
                    u32x4 w; w.x = cvt_pk_bf16(v0[0], v0[1]); w.y = cvt_pk_bf16(v0[2], v0[3]); w.z = cvt_pk_bf16(v1[0], v1[1]); w.w = cvt_pk_bf16(v1[2], v1[3]);
                    *(u32x4*)(rowp + bj * HALF) = w; }  asm volatile("" ::: "memory"); }
    }
};
struct EpiPlain8 {
    unsigned char* O; int ldc; float sc;
    __device__ __forceinline__ void operator()(const f32x4 (&acc)[2][2][4][2], const Unit& u, int wr, int wc, int fr, int fq) const {
        const int row0 = u.pm * BM + wr * 64 + fr, col0 = u.pn * BM + wc * 32 + 8 * fq;
#pragma unroll
        for (int ai = 0; ai < 2; ++ai)
#pragma unroll
            for (int m = 0; m < 4; ++m) { unsigned char* rowp = O + (size_t)(row0 + ai * HALF + m * 16) * ldc + col0;
#pragma unroll
                for (int bj = 0; bj < 2; ++bj) { const f32x4 v0 = acc[ai][bj][m][0], v1 = acc[ai][bj][m][1];
                    u32x2 w; w.x = pk4_fp8(v0[0] * sc, v0[1] * sc, v0[2] * sc, v0[3] * sc); w.y = pk4_fp8(v1[0] * sc, v1[1] * sc, v1[2] * sc, v1[3] * sc);
                    *(u32x2*)(rowp + bj * HALF) = w; } asm volatile("" ::: "memory"); }
    }
};
struct EpiMerge {
    unsigned char* O; const unsigned char* G; int nostore;
    static __device__ __forceinline__ void dec8(const u32x2 g, float (&f)[8]) {
        const f32x2 a = __builtin_amdgcn_cvt_pk_f32_fp8((int)g.x, false), b = __builtin_amdgcn_cvt_pk_f32_fp8((int)g.x, true), c = __builtin_amdgcn_cvt_pk_f32_fp8((int)g.y, false), d = __builtin_amdgcn_cvt_pk_f32_fp8((int)g.y, true);
        f[0] = a[0]; f[1] = a[1]; f[2] = b[0]; f[3] = b[1]; f[4] = c[0]; f[5] = c[1]; f[6] = d[0]; f[7] = d[1]; }
    __device__ __forceinline__ void mid(f32x4 (&acc)[2][2][4][2], const Unit& u, int wr, int wc, int fr, int fq) const {
        if (nostore) return;
        int lo = ((wr * 4 + wc) * 64 + fq * 16 + fr) * 8;
        asm volatile("" : "+v"(lo));
        const unsigned char* ga_p = G + ((size_t)u.pm * 4 + u.pn) * (BM * BM) + lo; const unsigned char* gb_p = ga_p + (size_t)(T / BM) * 4 * (BM * BM);
#pragma unroll
        for (int ai = 0; ai < 2; ++ai) {
            u32x2 gav[8], gbv[8];
#pragma unroll
            for (int i = 0; i < 8; ++i) { const int po = (ai * 8 + i) * 4096; gav[i] = *(const u32x2*)(ga_p + po); gbv[i] = *(const u32x2*)(gb_p + po); }
#pragma unroll
            for (int m = 0; m < 4; ++m)
#pragma unroll
                for (int bj = 0; bj < 2; ++bj) { float fa[8], fb[8]; dec8(gav[m * 2 + bj], fa); dec8(gbv[m * 2 + bj], fb);
#pragma unroll
                    for (int q = 0; q < 4; ++q) { acc[ai][bj][m][0][q] *= fa[q] * fast_rcp(fmaxf(fb[q], 0.001953125f)); acc[ai][bj][m][1][q] *= fa[4 + q] * fast_rcp(fmaxf(fb[4 + q], 0.001953125f)); } }
        }
    }
    __device__ __forceinline__ void operator()(const f32x4 (&acc)[2][2][4][2], const Unit& u, int wr, int wc, int fr, int fq) const {
        if (nostore) return;
        const int row0 = u.pm * BM + wr * 64 + fr, col0 = u.pn * BM + wc * 32 + 8 * fq;
        int lo_ = ((wr * 4 + wc) * 64 + fq * 16 + fr) * 8; asm volatile("" : "+v"(lo_));
        const unsigned char* gb_p = G + ((size_t)(T / BM + u.pm) * 4 + u.pn) * (BM * BM) + (size_t)lo_;
        constexpr float SO = SM8 / SG8;
        u32x2 gbv[16];
#pragma unroll
        for (int i = 0; i < 16; ++i) gbv[i] = *(const u32x2*)(gb_p + i * 4096);
#pragma unroll
        for (int ai = 0; ai < 2; ++ai)
#pragma unroll
            for (int m = 0; m < 4; ++m) { const size_t row = (size_t)(row0 + ai * HALF + m * 16);
                unsigned char* rowp = O + row * D + col0;
#pragma unroll
                for (int bj = 0; bj < 2; ++bj) { const f32x4 v0 = acc[ai][bj][m][0], v1 = acc[ai][bj][m][1];
                    float fb[8]; dec8(gbv[(ai * 4 + m) * 2 + bj], fb);
                    float o[8];
#pragma unroll
                    for (int q = 0; q < 4; ++q) { o[q] = fmaxf(fb[q], 0.001953125f) * v0[q] * SO; o[4 + q] = fmaxf(fb[4 + q], 0.001953125f) * v1[q] * SO; }
                    u32x2 w; w.x = pk4_fp8(o[0], o[1], o[2], o[3]); w.y = pk4_fp8(o[4], o[5], o[6], o[7]);
                    *(u32x2*)(rowp + bj * HALF) = w; } asm volatile("" ::: "memory"); }
    }
};
struct EpiSwiglu {
    unsigned char* O;
    __device__ __forceinline__ void operator()(const f32x4 (&acc)[2][2][4][2], const Unit& u, int wr, int wc, int fr, int fq) const {
        const int row0 = u.pm * BM + wr * 64 + fr, col0 = u.pn * HALF + wc * 32 + 8 * fq;
#pragma unroll
        for (int ai = 0; ai < 2; ++ai)
#pragma unroll
            for (int m = 0; m < 4; ++m) { unsigned char* rowp = O + (size_t)(row0 + ai * HALF + m * 16) * DE + col0;
                float o[8];
#pragma unroll
                for (int n = 0; n < 2; ++n)
#pragma unroll
                    for (int q = 0; q < 4; ++q) { const float g = acc[ai][0][m][n][q], up = acc[ai][1][m][n][q]; o[4 * n + q] = g * fast_rcp(1.0f + fast_exp2(-LOG2E * g)) * up * SH8; }
                u32x2 w; w.x = pk4_fp8(o[0], o[1], o[2], o[3]); w.y = pk4_fp8(o[4], o[5], o[6], o[7]);
                *(u32x2*)rowp = w; asm volatile("" ::: "memory"); }
    }
};

struct SchedStatic {
    const char* A; const char* Bt; int nM, nN, G, c; size_t tstep;
    __device__ __forceinline__ bool next(int i, Unit& u) const { u.aux = 0; return static_tile(nM, nN, G, c, i, u.pm, u.pn); }
    __device__ __forceinline__ const char* abase(const Unit& u) const { return A + (size_t)u.pm * tstep; }
    __device__ __forceinline__ const char* bbase(const Unit& u) const { return Bt + (size_t)u.pn * tstep; }
};
struct SchedTwoSeg {
    const char* A0; long adiff; const char* B0; long bdiff; int nM, nN, G, c; size_t tile_bytes;
    __device__ __forceinline__ bool next(int i, Unit& u) const { u.aux = 0; return static_tile(nM, nN, G, c, i, u.pm, u.pn); }
    __device__ __forceinline__ const char* abase(const Unit& u) const { return A0 + (size_t)u.pm * tile_bytes; }
    __device__ __forceinline__ const char* bbase(const Unit& u) const { return B0 + (size_t)u.pn * tile_bytes; }
};
struct SchedMoe {
    const char* A; const char* Bt; const int* tok; const LAS int* t2e; const LAS int* tstart; const LAS int* cnt; int ntiles, G, vcu; size_t a_tile_bytes, b_exp_bytes, b_tile_bytes; int row_bytes;
    __device__ __forceinline__ bool next(int i, Unit& u) const { const int L = i * G + vcu; if (L >= 4 * ntiles) return false; u.pm = L >> 2; u.pn = L & 3; u.aux = t2e[u.pm]; return true; }
    __device__ __forceinline__ const char* abase(const Unit& u) const { return A + (size_t)u.pm * a_tile_bytes; }
    __device__ __forceinline__ const char* bbase(const Unit& u) const { return Bt + (size_t)u.aux * b_exp_bytes + (size_t)u.pn * b_tile_bytes; }
    __device__ __forceinline__ void gather(const Unit& u, const int (&R)[2], const int (&C)[2], unsigned (&voff)[2][2]) const {
        const int e = u.aux, lt = u.pm - tstart[e], nvalid = cnt[e] - lt * 256; const int* list = tok + (size_t)e * TOKCAP + lt * 256;
#pragma unroll
        for (int h = 0; h < 2; ++h)
#pragma unroll
            for (int i = 0; i < 2; ++i) { int r = h * HALF + R[i]; r = r < nvalid ? r : nvalid - 1; const int t = list[r]; voff[h][i] = (unsigned)(t * row_bytes + C[i] * 2); }
    }
    __device__ __forceinline__ void gather_issue(const Unit& u, const int (&R)[2], unsigned (&raw)[2][2]) const {
        const int e = u.aux, lt = u.pm - tstart[e], nvalid = cnt[e] - lt * 256; const int* list = tok + (size_t)e * TOKCAP + lt * 256;
#pragma unroll
        for (int h = 0; h < 2; ++h)
#pragma unroll
            for (int i = 0; i < 2; ++i) { int r = h * HALF + R[i]; r = r < nvalid ? r : nvalid - 1; asm volatile("global_load_dword %0, %1, off" : "=v"(raw[h][i]) : "v"(list + r) : "memory"); }
    }
    __device__ __forceinline__ unsigned gather_finish(unsigned raw, int c) const { asm volatile("" : "+v"(raw)); return (unsigned)((int)raw * row_bytes + c * 2); }
};
}

struct Frame {
    LAS unsigned char* lds;
    gu32* ctl;
    int tid, lane, wave, vcu, G, bid;
};

__device__ __forceinline__ void p0_transpose_item(const float* W, int K, int N, bf16_t* WT, int k0, int n0, int dst_row0, float sc, LAS float* scr, int lane) {
    const int q = lane & 7, ks = lane >> 3;
    f32x4 vv[8];
#pragma unroll
    for (int it = 0; it < 8; ++it) asm volatile("global_load_dwordx4 %0, %1, off nt" : "=v"(vv[it]) : "v"(W + (size_t)(k0 + it * 8 + ks) * N + n0 + 4 * q) : "memory");
    asm volatile("s_waitcnt vmcnt(0)" : "+v"(vv[0]), "+v"(vv[1]), "+v"(vv[2]), "+v"(vv[3]), "+v"(vv[4]), "+v"(vv[5]), "+v"(vv[6]), "+v"(vv[7]) :: "memory");
#pragma unroll
    for (int it = 0; it < 8; ++it) { const int kk = it * 8 + ks; const f32x4 v = vv[it];
        scr[kk * 33 + 4 * q + 0] = v[0]; scr[kk * 33 + 4 * q + 1] = v[1]; scr[kk * 33 + 4 * q + 2] = v[2]; scr[kk * 33 + 4 * q + 3] = v[3]; }
    asm volatile("s_waitcnt lgkmcnt(0)" ::: "memory");
    const int c = lane & 7;
#pragma unroll
    for (int j = 0; j < 4; ++j) { const int n = (lane >> 3) + 8 * j; const LAS float* s = scr + (8 * c) * 33 + n;
        u32x4 o; o.x = cvt_pk_bf16(s[0 * 33] * sc, s[1 * 33] * sc); o.y = cvt_pk_bf16(s[2 * 33] * sc, s[3 * 33] * sc); o.z = cvt_pk_bf16(s[4 * 33] * sc, s[5 * 33] * sc); o.w = cvt_pk_bf16(s[6 * 33] * sc, s[7 * 33] * sc);
        __builtin_nontemporal_store(o, (u32x4*)(WT + (size_t)(dst_row0 + n) * K + k0 + 8 * c)); }
    asm volatile("s_waitcnt lgkmcnt(0)" ::: "memory");
}

__device__ __forceinline__ void p0_transpose_item_f8(const float* W, int K, int N, unsigned char* WT, int k0, int n0, int dst_row0, float sc, LAS float* scr, int lane) {
    const int q = lane & 7, ks = lane >> 3;
    f32x4 vv[8];
#pragma unroll
    for (int it = 0; it < 8; ++it) asm volatile("global_load_dwordx4 %0, %1, off nt" : "=v"(vv[it]) : "v"(W + (size_t)(k0 + it * 8 + ks) * N + n0 + 4 * q) : "memory");
    asm volatile("s_waitcnt vmcnt(0)" : "+v"(vv[0]), "+v"(vv[1]), "+v"(vv[2]), "+v"(vv[3]), "+v"(vv[4]), "+v"(vv[5]), "+v"(vv[6]), "+v"(vv[7]) :: "memory");
#pragma unroll
    for (int it = 0; it < 8; ++it) { const int kk = it * 8 + ks; const f32x4 v = vv[it];
        scr[kk * 33 + 4 * q + 0] = v[0]; scr[kk * 33 + 4 * q + 1] = v[1]; scr[kk * 33 + 4 * q + 2] = v[2]; scr[kk * 33 + 4 * q + 3] = v[3]; }
    asm volatile("s_waitcnt lgkmcnt(0)" ::: "memory");
    const int c = lane & 7;
#pragma unroll
    for (int j = 0; j < 4; ++j) { const int n = (lane >> 3) + 8 * j; const LAS float* s = scr + (8 * c) * 33 + n;
        u32x2 o; o.x = pk4_fp8(s[0 * 33] * sc, s[1 * 33] * sc, s[2 * 33] * sc, s[3 * 33] * sc); o.y = pk4_fp8(s[4 * 33] * sc, s[5 * 33] * sc, s[6 * 33] * sc, s[7 * 33] * sc);
        __builtin_nontemporal_store(o, (u32x2*)(WT + (size_t)(dst_row0 + n) * K + k0 + 8 * c)); }
    asm volatile("s_waitcnt lgkmcnt(0)" ::: "memory");
}

struct Args { const float* in[16]; float* out; unsigned char* ws; int ph_lo, ph_hi; };

constexpr int N_PHASES = 1 + 8 * DEPTH;


typedef const __attribute__((address_space(4))) Args* kargp_t;
extern __shared__ __attribute__((aligned(16))) unsigned char lds_raw[];
#define PHASE_ENTRY() Frame F; F.lds = (LAS unsigned char*)lds_raw; F.wave = wv; F.lane = lane_now(); F.tid = wv * 64 + F.lane; \
    F.G = gridDim.x; { int bx = blockIdx.x; asm volatile("" : "+s"(bx)); F.bid = bx; F.vcu = (F.G % 8 == 0) ? (bx % 8) * (F.G / 8) + bx / 8 : bx; } \
    kargp_t kp = (kargp_t)__builtin_amdgcn_kernarg_segment_ptr(); asm volatile("" : "+s"(kp)); unsigned char* ws = kp->ws; F.ctl = (gu32*)(ws + WS_CTL);
#define x_in (kp->in[0])
#define w_in (kp->in[1])
#define b_in (kp->in[2])
#define sinks (kp->in[3])
#define w_bra (kp->in[4])
#define w_brb (kp->in[5])
#define w_out (kp->in[6])
#define ln1_g (kp->in[7])
#define ln1_b (kp->in[8])
#define w_router (kp->in[9])
#define router_bias (kp->in[10])
#define w_gate (kp->in[11])
#define w_up (kp->in[12])
#define w_down (kp->in[13])
#define ln2_g (kp->in[14])
#define ln2_b (kp->in[15])
#define xres (kp->out)
#define bias_s ((float*)(ws + WS_BIAS))
#define Win_t ((bf16_t*)(ws + WS_WIN))
#define Wa_t ((bf16_t*)(ws + WS_WA))
#define Wb_t ((bf16_t*)(ws + WS_WB))
#define Wo_t ((bf16_t*)(ws + WS_WO))
#define Wgu_t ((bf16_t*)(ws + WS_WGU))
#define Wd_t ((bf16_t*)(ws + WS_WD))
#define xb ((bf16_t*)(ws + WS_XB))
#define proj ((bf16_t*)(ws + WS_PROJ))
#define hbuf ((bf16_t*)(ws + WS_H))
#define y2 ((bf16_t*)(ws + WS_Y2))
#define ya ((bf16_t*)(ws + WS_YA))
#define yb ((bf16_t*)(ws + WS_YB))
#define mix ((unsigned char*)(ws + WS_MIX))
#define merged ((bf16_t*)(ws + WS_MERGED))
#define tok ((int*)(ws + WS_TOK))
#define slot_e ((int*)(ws + WS_SLOT))
#define slot_r (slot_e + T * 2)
#define slot_g ((float*)(slot_r + T * 2))


namespace att {
typedef float f32x16 __attribute__((ext_vector_type(16)));
typedef short s16x4 __attribute__((ext_vector_type(4)));
typedef short v4i16_t __attribute__((ext_vector_type(4)));
constexpr int SLOTB = 8192, NSLOT = 6;
constexpr int LDS_K = 0, LDS_V = NSLOT * SLOTB, LDS_OST = 2 * NSLOT * SLOTB;
static_assert(LDS_OST + 8 * 4096 <= RING_BYTES, "attention LDS map");
__device__ __forceinline__ int crow(int r, int hi) { return (r & 3) + 8 * (r >> 2) + 4 * hi; }
__device__ __forceinline__ void glds16(const void* gsrc, unsigned lds_dst) { unsigned keep;
    asm volatile("s_mov_b32 %0, m0\n\ts_mov_b32 m0, %2\n\ts_nop 0\n\tglobal_load_lds_dwordx4 %1, off\n\ts_mov_b32 m0, %0" : "=&s"(keep) : "v"(gsrc), "s"(lds_dst) : "memory"); }
typedef const LAS char* lds_cptr;
__device__ __forceinline__ void kload8(bf16x8* kf, lds_cptr kp) {
    kf[0] = *(const LAS bf16x8*)(kp);        kf[1] = *(const LAS bf16x8*)(kp + 512);
    kf[2] = *(const LAS bf16x8*)(kp + 2048); kf[3] = *(const LAS bf16x8*)(kp + 2560);
    kf[4] = *(const LAS bf16x8*)(kp + 4096); kf[5] = *(const LAS bf16x8*)(kp + 4608);
    kf[6] = *(const LAS bf16x8*)(kp + 6144); kf[7] = *(const LAS bf16x8*)(kp + 6656);
}
__device__ __forceinline__ s16x4 vtr(lds_cptr p) { return __builtin_bit_cast(s16x4, __builtin_amdgcn_ds_read_tr16_b64_v4i16((LAS v4i16_t*)p)); }
__device__ __forceinline__ void qkt(f32x16& p0, f32x16& p1, const bf16x8* kf, const bf16x8* qr) {
    p0 = (f32x16){}; p1 = (f32x16){};
#pragma unroll
    for (int d0 = 0; d0 < 4; ++d0) { p0 = __builtin_amdgcn_mfma_f32_32x32x16_bf16(kf[2 * d0], qr[d0], p0, 0, 0, 0); p1 = __builtin_amdgcn_mfma_f32_32x32x16_bf16(kf[2 * d0 + 1], qr[d0], p1, 0, 0, 0); }
}
__device__ __forceinline__ void pv_ks(f32x16* o, lds_cptr vp, int ks, bf16x8 pa) {
#pragma unroll
    for (int d0 = 0; d0 < 2; ++d0) {
        const s16x4 lo = vtr(vp + d0 * 4096 + ks * 1024), hi = vtr(vp + d0 * 4096 + ks * 1024 + 512);
        const bf16x8 vf = (bf16x8){lo[0], lo[1], lo[2], lo[3], hi[0], hi[1], hi[2], hi[3]};
        o[d0] = __builtin_amdgcn_mfma_f32_32x32x16_bf16(pa, vf, o[d0], 0, 0, 0);
    }
}
__device__ __forceinline__ bf16x8 pack8(const f32x16& p, int b) {
    u32x4 w; w.x = cvt_pk_bf16(p[b], p[b + 1]); w.y = cvt_pk_bf16(p[b + 2], p[b + 3]); w.z = cvt_pk_bf16(p[b + 4], p[b + 5]); w.w = cvt_pk_bf16(p[b + 6], p[b + 7]);
    return __builtin_bit_cast(bf16x8, w);
}
__device__ __forceinline__ void store_o(const f32x16* o, LAS char* stage, unsigned char* dst, int ldo, int lane) {
    const int r32 = lane & 31, hi = lane >> 5;
    LAS unsigned char* stg = (LAS unsigned char*)stage;
#pragma unroll
    for (int r = 0; r < 16; ++r) { const int orow = crow(r, hi);
        const unsigned w = (unsigned)__builtin_amdgcn_cvt_pk_fp8_f32(o[0][r] * SY8, o[1][r] * SY8, 0, false);
        stg[orow * 64 + r32] = (unsigned char)(w & 0xffu); stg[orow * 64 + 32 + r32] = (unsigned char)((w >> 8) & 0xffu); }
    asm volatile("s_waitcnt lgkmcnt(0)" ::: "memory");
#pragma unroll
    for (int i = 0; i < 2; ++i) { const int piece = i * 64 + lane, row = piece >> 2, ch = piece & 3; const u32x4 v = *(const LAS u32x4*)(stg + row * 64 + ch * 16); *(u32x4*)(dst + (size_t)row * ldo + ch * 16) = v; }
    asm volatile("s_waitcnt lgkmcnt(0)" ::: "memory");
}
#define ATT_WAIT_BAR(N) asm volatile("s_waitcnt vmcnt(" #N ") lgkmcnt(0)\n\ts_barrier" ::: "memory")

__device__ __forceinline__ void sb_unit(int b, int hp, int qb, const bf16_t* pj, unsigned char* yout, LAS char* lds, LAS int* flags, int tid) {
    const int lane = tid & 63, r32 = lane & 31, hi = lane >> 5; const int wid = __builtin_amdgcn_readfirstlane(tid >> 6);
    const int grp = wid >> 2, lw = wid & 3, h = 2 * hp + grp;
    const size_t rowbase = (size_t)b * SEQ; const int q0 = qb * 128;
    const bf16_t* Qw = pj + (rowbase + q0 + lw * 32) * PP + C_SQ + h * 64;
    const bf16_t* Kh = pj + rowbase * PP + C_SK + h * 64; const bf16_t* Vh = pj + rowbase * PP + C_SV + h * 64;
    const unsigned lds0 = (unsigned)(uintptr_t)lds;
    const bf16_t* ksrc = Kh + (size_t)lane * PP + (2 * lw) * 8;
    const bf16_t* vsrc0 = Vh + (size_t)(16 * ((2 * lw) & 3) + (lane >> 2)) * PP + ((2 * lw) >> 2) * 32 + (lane & 3) * 8;
    const bf16_t* vsrc1 = Vh + (size_t)(16 * ((2 * lw + 1) & 3) + (lane >> 2)) * PP + ((2 * lw + 1) >> 2) * 32 + (lane & 3) * 8;
    const unsigned kdst = lds0 + LDS_K + grp * 3 * SLOTB + (2 * lw) * 1024, vdst = lds0 + LDS_V + grp * 3 * SLOTB + (2 * lw) * 1024;
#define SB_DMA(t, slot) do { const size_t to_ = (size_t)(t) * 64 * PP; \
        glds16(ksrc + to_, (unsigned)__builtin_amdgcn_readfirstlane(kdst + (slot))); glds16(ksrc + to_ + 8, (unsigned)__builtin_amdgcn_readfirstlane(kdst + (slot) + 1024)); \
        glds16(vsrc0 + to_, (unsigned)__builtin_amdgcn_readfirstlane(vdst + (slot))); glds16(vsrc1 + to_, (unsigned)__builtin_amdgcn_readfirstlane(vdst + (slot) + 1024)); } while (0)
    const lds_cptr kp0 = (lds_cptr)lds + LDS_K + grp * 3 * SLOTB + hi * 1024 + r32 * 16;
    const lds_cptr vp0 = (lds_cptr)lds + LDS_V + grp * 3 * SLOTB + ((lane >> 4) & 1) * 32 + (lane & 3) * 8 + (4 * hi + ((lane & 15) >> 2)) * 64;
    const int jhi = 2 * qb + 1, jw = 2 * qb + (lw >> 1);
    bf16x8 qr[4];
#pragma unroll
    for (int d0 = 0; d0 < 4; ++d0) qr[d0] = *(const bf16x8*)(Qw + (size_t)r32 * PP + d0 * 16 + hi * 8);
    SB_DMA(jhi, 0); SB_DMA(jhi - 1, SLOTB);
    asm volatile("s_waitcnt vmcnt(8)" : "+v"(qr[0]), "+v"(qr[1]), "+v"(qr[2]), "+v"(qr[3]) :: "memory");
    if (tid < 16) flags[tid] = 0;
    f32x16 o[2]; o[0] = (f32x16){}; o[1] = (f32x16){};
    float carry = 1.0f; bool done = false;
    const int trow = 32 * (lw & 1) + r32;
    const int lag = (lw < 2) ? 1 : 0;
    int sl_m = lag ? SLOTB : 0;
    int sl_cur = 0, sl_n2 = 2 * SLOTB;
    for (int n = 0;; ++n) {
        const int j = jhi - n; if (j < 0) break;
        ATT_WAIT_BAR(0);
        if (n > 0) { const LAS int* f = flags + ((n - 1) & 1) * 8; const int all = f[0] & f[1] & f[2] & f[3] & f[4] & f[5] & f[6] & f[7]; if (__builtin_amdgcn_readfirstlane(all)) break; }
        if (j >= 2) SB_DMA(j - 2, sl_n2);
        const int jm = j - lag;
        const bool active = (jm >= 0) && !done;
        if (active) {
            const bool diag = (jm == jw);
            const bool skip1 = diag && !(lw & 1);
            bf16x8 kf[8]; kload8(kf, kp0 + sl_m);
            f32x16 p0 = (f32x16){}, p1 = (f32x16){};
#pragma unroll
            for (int d0 = 0; d0 < 4; ++d0) p0 = __builtin_amdgcn_mfma_f32_32x32x16_bf16(kf[2 * d0], qr[d0], p0, 0, 0, 0);
            if (!skip1) {
#pragma unroll
                for (int d0 = 0; d0 < 4; ++d0) p1 = __builtin_amdgcn_mfma_f32_32x32x16_bf16(kf[2 * d0 + 1], qr[d0], p1, 0, 0, 0);
            }
            const int lim = diag ? trow : 4096;
            const lds_cptr vp = vp0 + sl_m;
#pragma unroll
            for (int blk = 1; blk >= 0; --blk) {
                if (blk == 1 && skip1) continue;
                f32x16& p = blk ? p1 : p0;
                float G[4];
#pragma unroll
                for (int g = 0; g < 4; ++g) {
#pragma unroll
                    for (int i = 0; i < 4; ++i) { const int r = 4 * g + i;
                        const float e = fast_exp2(p[r]); const float rr = fast_rcp(1.0f + e);
                        p[r] = rr; }
                    if (diag) {
#pragma unroll
                        for (int i = 0; i < 4; ++i) { const int r = 4 * g + i; p[r] = ((32 * blk + crow(r, hi)) < lim) ? p[r] : 1.0f; } }
                    G[g] = (p[4 * g] * p[4 * g + 1]) * (p[4 * g + 2] * p[4 * g + 3]);
                }
                float Tg[4], Gh[4]; float run = carry;
#pragma unroll
                for (int g = 3; g >= 0; --g) { const unsigned gu = __float_as_uint(G[g]); auto rrp = __builtin_amdgcn_permlane32_swap(gu, gu, false, false);
                    const float glo = __uint_as_float(rrp[0]), ghi = __uint_as_float(rrp[1]); Tg[g] = run; Gh[g] = ghi; run = run * (glo * ghi); }
                carry = run;
#pragma unroll
                for (int g = 0; g < 4; ++g) { float x = hi ? Tg[g] : Tg[g] * Gh[g];
                    const float k0 = p[4 * g], k1 = p[4 * g + 1], k2 = p[4 * g + 2], k3 = p[4 * g + 3];
                    float xn = x * k3; p[4 * g + 3] = x - xn; x = xn; xn = x * k2; p[4 * g + 2] = x - xn; x = xn; xn = x * k1; p[4 * g + 1] = x - xn; x = xn; p[4 * g] = x - x * k0; }
                pv_ks(o, vp, 2 * blk, pack8(p, 0)); pv_ks(o, vp, 2 * blk + 1, pack8(p, 8));
            }
            done = __all(carry < 1e-37f) || (jm == 0);
        }
        if (lane == 0) flags[(n & 1) * 8 + wid] = (done || (jm <= 0)) ? 1 : 0;
        { const int t_ = sl_cur; sl_cur = (sl_cur == 2 * SLOTB) ? 0 : sl_cur + SLOTB; sl_n2 = t_; sl_m = (sl_m == 2 * SLOTB) ? 0 : sl_m + SLOTB; }
    }
    asm volatile("s_waitcnt vmcnt(0)" ::: "memory");
    store_o(o, lds + LDS_OST + wid * 4096, yout + (rowbase + q0 + lw * 32) * 512 + h * 64, 512, lane);
    asm volatile("s_waitcnt lgkmcnt(0)\n\ts_barrier" ::: "memory");
#undef SB_DMA
}

__device__ __forceinline__ void swa_dma(const bf16_t* pj, int u, unsigned lds0, int set, int lane, int wid) {
    const int a = u & 31, kvh = (u >> 5) & 1, b = u >> 6;
    const bf16_t* Kh = pj + (size_t)b * SEQ * PP + C_AK + kvh * 64; const bf16_t* Vh = pj + (size_t)b * SEQ * PP + C_AV + kvh * 64;
#pragma unroll
    for (int i = 0; i < 3; ++i) { int jt = a - 2 + i; jt = jt < 0 ? 0 : jt;
        glds16(Kh + ((size_t)jt * 64 + lane) * PP + wid * 8, (unsigned)__builtin_amdgcn_readfirstlane(lds0 + LDS_K + (set * 3 + i) * SLOTB + wid * 1024));
        glds16(Vh + ((size_t)jt * 64 + 16 * (wid & 3) + (lane >> 2)) * PP + (wid >> 2) * 32 + (lane & 3) * 8, (unsigned)__builtin_amdgcn_readfirstlane(lds0 + LDS_V + (set * 3 + i) * SLOTB + wid * 1024)); }
}
__device__ __forceinline__ void swa_q(bf16x8* qr, const bf16_t* pj, int u, int lane, int wid) {
    const int a = u & 31, kvh = (u >> 5) & 1, b = u >> 6, g = wid >> 1, half = wid & 1, qh = kvh * 4 + g, r32 = lane & 31, hi = lane >> 5;
    const size_t row0 = (size_t)b * SEQ + a * 64 + half * 32;
#pragma unroll
    for (int d0 = 0; d0 < 4; ++d0) qr[d0] = *(const bf16x8*)(pj + (row0 + r32) * PP + C_AQ + qh * 64 + d0 * 16 + hi * 8);
}
__device__ __forceinline__ void swa_unit(int u, int set, const bf16x8* qr, unsigned char* yout, const float* sinks_l, LAS char* lds, int tid) {
    const int lane = tid & 63, r32 = lane & 31, hi = lane >> 5; const int wid = __builtin_amdgcn_readfirstlane(tid >> 6);
    const int a = u & 31, kvh = (u >> 5) & 1, b = u >> 6, g = wid >> 1, half = wid & 1, qh = kvh * 4 + g;
    const size_t row0 = (size_t)b * SEQ + a * 64 + half * 32;
    unsigned sk_; { const float* sp_ = sinks_l + qh; asm volatile("s_load_dword %0, %1, 0x0\n\ts_waitcnt lgkmcnt(0)" : "=s"(sk_) : "s"(sp_) : "memory"); }
    const float slope2 = LOG2E * exp2f(-(float)(qh + 1)), sink2 = __uint_as_float(sk_) * LOG2E;
    const lds_cptr kp0 = (lds_cptr)lds + LDS_K + set * 3 * SLOTB + hi * 1024 + r32 * 16;
    const lds_cptr vp0 = (lds_cptr)lds + LDS_V + set * 3 * SLOTB + ((lane >> 4) & 1) * 32 + (lane & 3) * 8 + (4 * hi + ((lane & 15) >> 2)) * 64;
    f32x16 s[3][2];
#pragma unroll
    for (int i = 0; i < 3; ++i) { bf16x8 kf[8]; kload8(kf, kp0 + i * SLOTB);
        s[i][0] = (f32x16){}; s[i][1] = (f32x16){};
        if (!(i == 0 && half == 1)) {
#pragma unroll
            for (int d0 = 0; d0 < 4; ++d0) s[i][0] = __builtin_amdgcn_mfma_f32_32x32x16_bf16(kf[2 * d0], qr[d0], s[i][0], 0, 0, 0); }
        if (!(i == 2 && half == 0)) {
#pragma unroll
            for (int d0 = 0; d0 < 4; ++d0) s[i][1] = __builtin_amdgcn_mfma_f32_32x32x16_bf16(kf[2 * d0 + 1], qr[d0], s[i][1], 0, 0, 0); } }
    float m = sink2;
#pragma unroll
    for (int i = 0; i < 3; ++i) { const bool tile_ok = (a - 2 + i) >= 0;
#pragma unroll
        for (int blk = 0; blk < 2; ++blk) { const int dbase = 64 * (2 - i) + 32 * half + r32 - 32 * blk;
#pragma unroll
            for (int r = 0; r < 16; ++r) { const int dist = dbase - crow(r, hi); const bool valid = tile_ok && dist >= 0 && dist < 128;
                const float v = s[i][blk][r] - slope2 * (float)dist; s[i][blk][r] = valid ? v : -INFINITY; m = fmaxf(m, s[i][blk][r]); } } }
    { const unsigned mu = __float_as_uint(m); auto rr = __builtin_amdgcn_permlane32_swap(mu, mu, false, false); m = fmaxf(__uint_as_float(rr[0]), __uint_as_float(rr[1])); }
    float lsum = 0.f;
#pragma unroll
    for (int i = 0; i < 3; ++i)
#pragma unroll
        for (int blk = 0; blk < 2; ++blk)
#pragma unroll
            for (int r = 0; r < 16; ++r) { const float pe = fast_exp2(s[i][blk][r] - m); s[i][blk][r] = pe; lsum += pe; }
    { const unsigned lu = __float_as_uint(lsum); auto rr = __builtin_amdgcn_permlane32_swap(lu, lu, false, false); lsum = __uint_as_float(rr[0]) + __uint_as_float(rr[1]); }
    const float inv = 1.0f / (lsum + fast_exp2(sink2 - m));
    f32x16 o[2]; o[0] = (f32x16){}; o[1] = (f32x16){};
#pragma unroll
    for (int i = 0; i < 3; ++i)
#pragma unroll
        for (int blk = 0; blk < 2; ++blk) {
            if ((i == 0 && blk == 0 && half == 1) || (i == 2 && blk == 1 && half == 0)) continue;
#pragma unroll
            for (int r = 0; r < 16; ++r) s[i][blk][r] *= inv;
            pv_ks(o, vp0 + i * SLOTB, 2 * blk, pack8(s[i][blk], 0)); pv_ks(o, vp0 + i * SLOTB, 2 * blk + 1, pack8(s[i][blk], 8)); }
    store_o(o, lds + LDS_OST + wid * 4096, yout + row0 * 512 + qh * 64, 512, lane);
}
}

__device__ __forceinline__ void phase_attn_mfma(int l, const int wv) {
    PHASE_ENTRY();
    LAS char* lds = (LAS char*)F.lds; LAS int* flags = (LAS int*)(F.lds + LC_HIST);
    const bool xmap = (F.G == 256); const int u_first = xmap ? (F.vcu >> 5) * 128 + (F.vcu & 31) : F.bid, u_step = xmap ? 32 : F.G;
    const int sb_end = xmap ? (F.vcu >> 5) * 128 + 128 : BATCH * 4 * 16, swa_end = xmap ? (F.vcu >> 5) * 128 + 128 : BATCH * 2 * 32;
    for (int rep_ = 0; rep_ < NREP(9); ++rep_)
    for (int u = u_first; u < sb_end; u += u_step) { const int qb = ((u & 15) + (xmap ? ((u >> 5) & 3) : (u >> 8)) * 5) & 15;
        att::sb_unit(u >> 6, (u >> 4) & 3, qb, proj, (unsigned char*)(ws + WS_YA + 16 * MiB), lds, flags, F.tid); }
    for (int rep_ = 0; rep_ < NREP(10); ++rep_) {
    const unsigned lds0 = (unsigned)(uintptr_t)lds; int set = 0;
    bf16x8 qc[4], qn[4];
#pragma unroll
    for (int d0 = 0; d0 < 4; ++d0) { qc[d0] = (bf16x8){}; qn[d0] = (bf16x8){}; }
    if (u_first < swa_end) { att::swa_q(qc, proj, u_first, F.lane, F.wave); att::swa_dma(proj, u_first, lds0, 0, F.lane, F.wave); }
    for (int u = u_first; u < swa_end; u += u_step) {
        ATT_WAIT_BAR(0);
        const bool more = (u + u_step < swa_end);
        if (more) { att::swa_q(qn, proj, u + u_step, F.lane, F.wave); att::swa_dma(proj, u + u_step, lds0, set ^ 1, F.lane, F.wave); }
        att::swa_unit(u, set, qc, (unsigned char*)(ws + WS_YA), sinks + l * 8, lds, F.tid);
        if (more) {
#pragma unroll
            for (int d0 = 0; d0 < 4; ++d0) qc[d0] = qn[d0]; }
        set ^= 1;
    }
    asm volatile("s_waitcnt vmcnt(0) lgkmcnt(0)\n\ts_barrier" ::: "memory");
    }
}


__device__ __forceinline__ int moe_tables(Frame& F, int l) {
    LAS int* cnt = (LAS int*)(F.lds + LC_CNT); LAS int* tstart = (LAS int*)(F.lds + LC_TSTART); LAS int* t2e = (LAS int*)(F.lds + LC_T2E);
    __syncthreads();
    if (F.tid < NE) cnt[F.tid] = (int)__hip_atomic_load(F.ctl + CW_CNT + 64 * l + F.tid, __ATOMIC_RELAXED, __HIP_MEMORY_SCOPE_AGENT);
    __syncthreads();
    if (F.tid == 0) { int s = 0; for (int e = 0; e < NE; ++e) { tstart[e] = s; s += (cnt[e] + 255) >> 8; } tstart[NE] = s; }
    __syncthreads();
    if (F.tid < NE) { const int s = tstart[F.tid], n = (cnt[F.tid] + 255) >> 8; for (int j = 0; j < n; ++j) t2e[s + j] = F.tid; }
    __syncthreads();
    return tstart[NE];
}
__device__ __forceinline__ int moe_tables_cached(Frame& F, int l) {
#if MK_ONE_LAUNCH
    (void)l; return ((const LAS int*)(F.lds + LC_TSTART))[NE];
#else
    return moe_tables(F, l);
#endif
}


constexpr int CI_IN = (D / 64) * (NIN / 32), CI_BR = (512 / 64) * (D / 32), CI_WO = (D / 64) * (D / 32), CI_GU = NE * (D / 64) * (DE / 32), CI_DN = NE * (DE / 64) * (D / 32);
constexpr int NPL = CI_IN + 2 * CI_BR + CI_WO + 2 * CI_GU + CI_DN;
__device__ __forceinline__ void convert_item(kargp_t kp, unsigned char* ws, int l, int r, LAS float* scr, int lane) {
    const float* W; unsigned char* WT; int K, N, k0, n0, drow; float sc = 1.0f; bool f8 = true;
    if (r < CI_IN) { const int kb = r / (NIN / 32), nb = r % (NIN / 32); n0 = nb * 32; k0 = kb * 64; drow = n0; K = D; N = NIN;
        sc = (((n0 < C_AK) || (n0 >= C_SQ && n0 < C_SK)) ? C2 : 1.0f) * SW8; W = w_in + (size_t)l * D * NIN; WT = (unsigned char*)(ws + WS_WIN) + (size_t)l * NIN * D; }
    else if ((r -= CI_IN) < 2 * CI_BR) { const int bb = r >= CI_BR; if (bb) r -= CI_BR; const int kb = r / (D / 32), nb = r % (D / 32); n0 = nb * 32; k0 = kb * 64; drow = n0; K = 512; N = D; sc = SW8;
        W = (bb ? w_brb : w_bra) + (size_t)l * 512 * D; WT = (unsigned char*)(ws + (bb ? WS_WB : WS_WA)) + (size_t)l * D * 512; }
    else if ((r -= 2 * CI_BR) < CI_WO) { const int kb = r / (D / 32), nb = r % (D / 32); n0 = nb * 32; k0 = kb * 64; drow = n0; K = D; N = D; sc = SW8;
        W = w_out + (size_t)l * D * D; WT = (unsigned char*)(ws + WS_WO) + (size_t)l * D * D; }
    else if ((r -= CI_WO) < 2 * CI_GU) { sc = SW8; const int up = r >= CI_GU; if (up) r -= CI_GU; constexpr int per = (D / 64) * (DE / 32); const int le = l * NE + r / per, q = r % per, kb = q / (DE / 32), nb = q % (DE / 32);
        n0 = nb * 32; k0 = kb * 64; drow = (n0 >> 7) * 256 + (n0 & 127) + (up ? 128 : 0); K = D; N = DE;
        W = (up ? w_up : w_gate) + (size_t)le * D * DE; WT = (unsigned char*)(ws + WS_WGU) + (size_t)le * 1024 * D; }
    else { r -= 2 * CI_GU; constexpr int per = (DE / 64) * (D / 32); const int le = l * NE + r / per, q = r % per, kb = q / (D / 32), nb = q % (D / 32); n0 = nb * 32; k0 = kb * 64; drow = n0; K = DE; N = D; sc = SW8;
        W = w_down + (size_t)le * DE * D; WT = (unsigned char*)(ws + WS_WD) + (size_t)le * D * DE; }
    if (f8) p0_transpose_item_f8(W, K, N, WT, k0, n0, drow, sc, scr, lane);
    else p0_transpose_item(W, K, N, (bf16_t*)WT, k0, n0, drow, sc, scr, lane);
}
constexpr int CW_CQ = 12288;
constexpr int QB = 32, QTOTAL = (DEPTH - 1) * NPL;
static_assert(QTOTAL % QB == 0, "queue batches");
constexpr int LW_REL = 12, LW_Q = 13, LW_GEN = 14, LW_QDONE = 15;
__device__ __forceinline__ int cq_take(unsigned char* ws, int lane, int claim_limit) {
    volatile LAS int* misc = (volatile LAS int*)((LAS unsigned char*)lds_raw + LC_MISC);
    gu32* cq = (gu32*)(ws + WS_CTL) + CW_CQ;
    for (int tries = 0; tries < (1 << 20); ++tries) {
        if (misc[LW_QDONE]) return -1;
        int old = 0;
        if (lane == 0) old = __hip_atomic_fetch_add((LAS int*)((LAS unsigned char*)lds_raw + LC_MISC) + LW_Q, 1, __ATOMIC_RELAXED, __HIP_MEMORY_SCOPE_WORKGROUP);
        old = __builtin_amdgcn_readfirstlane(old);
        const int i = old & 255, batch = (int)((unsigned)old >> 8);
        if (i < QB) return batch * QB + i;
        if (i == QB) {
            int nb = -1;
            if (lane == 0) { const int p = (int)__hip_atomic_load(cq, __ATOMIC_RELAXED, __HIP_MEMORY_SCOPE_AGENT); if (p * QB < claim_limit) nb = (int)__hip_atomic_fetch_add(cq, 1u, __ATOMIC_RELAXED, __HIP_MEMORY_SCOPE_AGENT); }
            nb = __builtin_amdgcn_readfirstlane(nb);
            if (nb < 0) { if (lane == 0) misc[LW_Q] = (batch << 8) | QB; return -1; }
            if (nb * QB >= QTOTAL) { if (lane == 0) { misc[LW_QDONE] = 1; misc[LW_Q] = (batch << 8) | QB; } return -1; }
            if (lane == 0) misc[LW_Q] = (nb << 8) | 1;
            return nb * QB;
        }
        while ((misc[LW_Q] & 255) > QB && !misc[LW_QDONE]) __builtin_amdgcn_s_sleep(2);
    }
    return -1;
}
__device__ __forceinline__ bool cq_step(kargp_t kp, unsigned char* ws, LAS float* scr, int lane, int claim_limit) {
    const int k = cq_take(ws, lane, claim_limit);
    if (k < 0) return false;
    convert_item(kp, ws, 1 + k / NPL, k % NPL, scr, lane);
    return true;
}

__device__ __forceinline__ void phase_prologue(const int wv) {
    PHASE_ENTRY();
    LAS float* scr = (LAS float*)(F.lds + F.wave * 16384);
    const int gw = F.vcu * NWAVES + F.wave, NGW = F.G * NWAVES;
#if MK_ONE_LAUNCH
    constexpr int NL0 = 1;
#else
    constexpr int NL0 = DEPTH;
#endif
    for (int it = gw; it < NL0 * NPL; it += NGW) convert_item(kp, ws, it / NPL, it % NPL, scr, F.lane);
    { const size_t NV = (size_t)T * D / 4, st = (size_t)F.G * NTHREADS;
      for (size_t i0 = (size_t)F.bid * NTHREADS + F.tid; i0 < NV; i0 += 8 * st) {
        f32x4 v[8];
#pragma unroll
        for (int k = 0; k < 8; ++k) { const size_t i = i0 + k * st; v[k] = (i < NV) ? __builtin_nontemporal_load((const f32x4*)x_in + i) : (f32x4){}; }
#pragma unroll
        for (int k = 0; k < 8; ++k) { const size_t i = i0 + k * st; if (i < NV) { u32x2 o; o.x = cvt_pk_bf16(v[k][0], v[k][1]); o.y = cvt_pk_bf16(v[k][2], v[k][3]); ((u32x2*)xb)[i] = o;
            ((unsigned*)(ws + WS_XF8))[i] = pk4_fp8(v[k][0] * SX8, v[k][1] * SX8, v[k][2] * SX8, v[k][3] * SX8); } }
      } }
    for (int i = F.bid * NTHREADS + F.tid; i < DEPTH * NIN; i += F.G * NTHREADS) { const int n = i % NIN; bias_s[i] = b_in[i] * (((n < C_AK) || (n >= C_SQ && n < C_SK)) ? C2 : 1.0f); }
}

__device__ __forceinline__ void phase_ln1(int l, const bool dummy, const int wv) {
    PHASE_ENTRY();
    bf16_t* xdst = dummy ? merged : xb;
    LAS unsigned char* Tb = F.lds;
    LAS float* red = (LAS float*)F.lds;
    LAS float* Lg = (LAS float*)(F.lds + LC_LOGIT);
    LAS int* hist = (LAS int*)(F.lds + LC_HIST); LAS int* basev = (LAS int*)(F.lds + LC_BASE);
    LAS int* se = (LAS int*)(F.lds + LC_SE); LAS int* sr = (LAS int*)(F.lds + LC_SR); LAS float* sg = (LAS float*)(F.lds + LC_SG);
    const int hh = F.lane >> 5, jx = F.lane & 31;
    { LAS float* gb = (LAS float*)(F.lds + LC_GB);
      *(LAS f32x2*)(gb + 2 * F.tid) = *(const f32x2*)(ln1_g + l * D + 2 * F.tid); *(LAS f32x2*)(gb + D + 2 * F.tid) = *(const f32x2*)(ln1_b + l * D + 2 * F.tid);
      if (F.tid < NE) ((LAS float*)(F.lds + LC_RB))[F.tid] = router_bias[F.tid]; }
    bf16x8 bwh[8], bwl[8];
    float wraw[64];
#pragma unroll
    for (int s = 0; s < 64; ++s) wraw[s] = w_router[(size_t)(128 * F.wave + 16 * (s >> 3) + 8 * hh + (s & 7)) * NE + jx];
#pragma unroll
    for (int s = 0; s < 8; ++s)
#pragma unroll
        for (int i = 0; i < 8; i += 2) { const float w0 = wraw[8 * s + i], w1 = wraw[8 * s + i + 1];
            const unsigned h = cvt_pk_bf16(w0, w1); const unsigned lo = cvt_pk_bf16(w0 - bf_lo(h), w1 - bf_hi(h));
            bwh[s][i] = (short)(h & 0xffffu); bwh[s][i + 1] = (short)(h >> 16); bwl[s][i] = (short)(lo & 0xffffu); bwl[s][i + 1] = (short)(lo >> 16); }
    for (int rb = (F.G == 256) ? F.vcu : F.bid; rb < T / 128; rb += F.G) {
        if (F.tid < NE) hist[F.tid] = 0;
        __syncthreads();
        u32x2 xr[4][4]; unsigned mr[4][4];
#define LN1_LOAD_ROUND(rnd) do { _Pragma("unroll") for (int q_ = 0; q_ < 4; ++q_) { const size_t row_ = (size_t)rb * 128 + (rnd) * 32 + 4 * F.wave + q_; \
            _Pragma("unroll") for (int j_ = 0; j_ < 4; ++j_) { xr[q_][j_] = *(const u32x2*)(xb + row_ * D + 256 * j_ + 4 * F.lane); mr[q_][j_] = *(const unsigned*)((const unsigned char*)mix + row_ * D + 256 * j_ + 4 * F.lane); } } } while (0)
        LN1_LOAD_ROUND(0);
        for (int round = 0; round < 4; ++round) {
#pragma unroll
            for (int qp = 0; qp < 4; qp += 2) {
                f32x4 v[2][4]; float s[2], s2[2];
#pragma unroll
                for (int q = 0; q < 2; ++q) { s[q] = 0.f;
#pragma unroll
                    for (int j = 0; j < 4; ++j) { const u32x2 xv = xr[qp + q][j]; const f32x2 m01 = __builtin_amdgcn_cvt_pk_f32_fp8((int)mr[qp + q][j], false), m23 = __builtin_amdgcn_cvt_pk_f32_fp8((int)mr[qp + q][j], true);
                        v[q][j][0] = ALPHA * bf_lo(xv.x) + m01[0] * (1.0f / SMX8); v[q][j][1] = ALPHA * bf_hi(xv.x) + m01[1] * (1.0f / SMX8); v[q][j][2] = ALPHA * bf_lo(xv.y) + m23[0] * (1.0f / SMX8); v[q][j][3] = ALPHA * bf_hi(xv.y) + m23[1] * (1.0f / SMX8);
                        s[q] += (v[q][j][0] + v[q][j][1]) + (v[q][j][2] + v[q][j][3]); } }
                s[0] = wave_sum(s[0]); s[1] = wave_sum(s[1]);
#pragma unroll
                for (int q = 0; q < 2; ++q) { const float mean = s[q] * (1.f / D); s2[q] = 0.f;
#pragma unroll
                    for (int j = 0; j < 4; ++j) { v[q][j] = v[q][j] - mean; s2[q] += (v[q][j][0] * v[q][j][0] + v[q][j][1] * v[q][j][1]) + (v[q][j][2] * v[q][j][2] + v[q][j][3] * v[q][j][3]); } }
                s2[0] = wave_sum(s2[0]); s2[1] = wave_sum(s2[1]);
#pragma unroll
                for (int q = 0; q < 2; ++q) {
                    const int r32 = 4 * F.wave + qp + q; const size_t row = (size_t)rb * 128 + round * 32 + r32;
                    const float rstd = 1.f / sqrtf(s2[q] * (1.f / D) + LN_EPS);
#pragma unroll
                    for (int j = 0; j < 4; ++j) { const f32x4 gam = *(const LAS f32x4*)(F.lds + LC_GB + (256 * j + 4 * F.lane) * 4), bet = *(const LAS f32x4*)(F.lds + LC_GB + (D + 256 * j + 4 * F.lane) * 4); const f32x4 y = v[q][j] * rstd * gam + bet;
                        u32x2 o; o.x = cvt_pk_bf16(y[0], y[1]); o.y = cvt_pk_bf16(y[2], y[3]); *(u32x2*)(xdst + row * D + 256 * j + 4 * F.lane) = o;
                        if (!dummy) *(unsigned*)(ws + WS_XF8 + row * D + 256 * j + 4 * F.lane) = pk4_fp8(y[0] * SX8, y[1] * SX8, y[2] * SX8, y[3] * SX8);
                        *(LAS u32x2*)(Tb + r32 * 2064 + (256 * j + 4 * F.lane) * 2) = o; }
                }
            }
            if (round < 3) LN1_LOAD_ROUND(round + 1);
            __syncthreads();
            att::f32x16 acc = (att::f32x16){};
            { const LAS unsigned char* ap = Tb + jx * 2064 + (128 * F.wave + 8 * hh) * 2;
#pragma unroll
              for (int s = 0; s < 8; ++s) { const bf16x8 av = *(const LAS bf16x8*)(ap + 32 * s);
                  acc = __builtin_amdgcn_mfma_f32_32x32x16_bf16(av, bwh[s], acc, 0, 0, 0); acc = __builtin_amdgcn_mfma_f32_32x32x16_bf16(av, bwl[s], acc, 0, 0, 0); } }
            __syncthreads();
#pragma unroll
            for (int r = 0; r < 16; ++r) red[(F.wave * 32 + att::crow(r, hh)) * 32 + jx] = acc[r];
            __syncthreads();
#pragma unroll
            for (int p = 0; p < 2; ++p) { const int idx = F.tid + 512 * p, tk = idx >> 5, e = idx & 31; float s = 0.f;
#pragma unroll
                for (int w = 0; w < 8; ++w) s += red[(w * 32 + tk) * 32 + e];
                Lg[(round * 32 + tk) * 33 + e] = s; }
            __syncthreads();
        }
        __syncthreads();
        if (F.tid < 128) {
                const LAS float* lgp = Lg + F.tid * 33;
                float best = -3.0e38f; int gsel = 0; float b4[4], a4[4];
#pragma unroll
                for (int i = 0; i < 4; ++i) { b4[i] = 0.f; a4[i] = 0.f; }
#pragma unroll
                for (int g = 0; g < 8; ++g) { float af[4], bi[4];
#pragma unroll
                    for (int i = 0; i < 4; ++i) { const float lg = lgp[4 * g + i]; af[i] = 1.0f / (1.0f + __expf(-lg)); bi[i] = af[i] + ((const LAS float*)(F.lds + LC_RB))[4 * g + i]; }
                    const float h1 = fmaxf(bi[0], bi[1]), l1 = fminf(bi[0], bi[1]), h2 = fmaxf(bi[2], bi[3]), l2 = fminf(bi[2], bi[3]);
                    const float gs = fmaxf(h1, h2) + fmaxf(fminf(h1, h2), fmaxf(l1, l2));
                    const bool better = gs > best; best = better ? gs : best; gsel = better ? g : gsel;
#pragma unroll
                    for (int i = 0; i < 4; ++i) { b4[i] = better ? bi[i] : b4[i]; a4[i] = better ? af[i] : a4[i]; } }
                int i1 = 0; float m1 = b4[0];
#pragma unroll
                for (int i = 1; i < 4; ++i) { const bool gt = b4[i] > m1; m1 = gt ? b4[i] : m1; i1 = gt ? i : i1; }
                int i2 = -1; float m2 = -3.0e38f;
#pragma unroll
                for (int i = 0; i < 4; ++i) { const bool gt = (i != i1) && (b4[i] > m2); m2 = gt ? b4[i] : m2; i2 = gt ? i : i2; }
                float w1 = a4[0], w2 = a4[0];
#pragma unroll
                for (int i = 1; i < 4; ++i) { w1 = (i1 == i) ? a4[i] : w1; w2 = (i2 == i) ? a4[i] : w2; }
                const float wsum = w1 + w2;
                const int e1 = gsel * 4 + i1, e2 = gsel * 4 + i2, rloc = F.tid;
                if (dummy) { asm volatile("" :: "v"(e1), "v"(e2), "v"(wsum)); } else {
                const int r1 = __hip_atomic_fetch_add(hist + e1, 1, __ATOMIC_RELAXED, __HIP_MEMORY_SCOPE_WORKGROUP);
                const int r2 = __hip_atomic_fetch_add(hist + e2, 1, __ATOMIC_RELAXED, __HIP_MEMORY_SCOPE_WORKGROUP);
                se[2 * rloc] = e1; se[2 * rloc + 1] = e2; sr[2 * rloc] = r1; sr[2 * rloc + 1] = r2; sg[2 * rloc] = w1 / wsum; sg[2 * rloc + 1] = w2 / wsum; }
            }
        __syncthreads();
        if (F.tid < NE && !dummy) basev[F.tid] = (int)__hip_atomic_fetch_add(F.ctl + CW_CNT + 64 * l + F.tid, (unsigned)hist[F.tid], __ATOMIC_RELAXED, __HIP_MEMORY_SCOPE_AGENT);
        __syncthreads();
        if (F.tid < 256 && !dummy) { const int e = se[F.tid], rk = basev[e] + sr[F.tid]; const int t = rb * 128 + (F.tid >> 1);
            tok[(size_t)e * TOKCAP + rk] = t; slot_e[(size_t)t * 2 + (F.tid & 1)] = e; slot_r[(size_t)t * 2 + (F.tid & 1)] = rk; slot_g[(size_t)t * 2 + (F.tid & 1)] = sg[F.tid]; }
        __syncthreads();
    }
}

__device__ __forceinline__ void phase_ln2(int l, const bool dummy, const int wv) {
    PHASE_ENTRY();
    bf16_t* xdst = dummy ? merged : xb; float* fdst = dummy ? (float*)(ws + WS_YA) : xres;

            (void)moe_tables_cached(F, l);
            const LAS int* tstart = (const LAS int*)(F.lds + LC_TSTART);
            f32x4 gam[4], bet[4];
#pragma unroll
            for (int j = 0; j < 4; ++j) { gam[j] = *(const f32x4*)(ln2_g + l * D + 256 * j + 4 * F.lane); bet[j] = *(const f32x4*)(ln2_b + l * D + 256 * j + 4 * F.lane); }
            const int gw = F.bid * NWAVES + F.wave, NGW = F.G * NWAVES;
            const bool xmap = (F.G == 256); const int r_first = xmap ? 128 * F.vcu + F.wave : gw, r_pair = xmap ? 8 : NGW, r_end = xmap ? 128 * F.vcu + 128 : T;
            for (int itb = 0; r_first + 2 * r_pair * itb < r_end; itb += 16) {
            int pv; float gv;
            { const int myrow = r_first + 2 * r_pair * (itb + (F.lane >> 2)) + ((F.lane >> 1) & 1) * r_pair; const int rr = myrow < r_end ? myrow : r_first;
              const int e = slot_e[(size_t)rr * 2 + (F.lane & 1)], r = slot_r[(size_t)rr * 2 + (F.lane & 1)]; gv = slot_g[(size_t)rr * 2 + (F.lane & 1)] * (1.0f / SY28);
              pv = tstart[e] * 256 + r; }
            u32x2 xw[2][4], xn[2][4]; unsigned ya_[2][4], yb_[2][4], yan[2][4], ybn[2][4];
#define LN2_LOAD(jj_, XW, YA, YB) do { const int row0_ = r_first + 2 * r_pair * (itb + (jj_)); _Pragma("unroll") for (int q = 0; q < 2; ++q) { const int row_ = row0_ + q * r_pair; const int rr_ = row_ < r_end ? row_ : row0_; \
                    const size_t p0 = (size_t)__builtin_amdgcn_readlane(pv, 4 * (jj_) + 2 * q), p1 = (size_t)__builtin_amdgcn_readlane(pv, 4 * (jj_) + 2 * q + 1); \
                    _Pragma("unroll") for (int j = 0; j < 4; ++j) { XW[q][j] = *(const u32x2*)(xb + (size_t)rr_ * D + 256 * j + 4 * F.lane); \
                        YA[q][j] = *(const unsigned*)(ws + WS_Y2 + p0 * D + 256 * j + 4 * F.lane); YB[q][j] = *(const unsigned*)(ws + WS_Y2 + p1 * D + 256 * j + 4 * F.lane); } } } while (0)
            LN2_LOAD(0, xw, ya_, yb_);
            for (int jj = 0; jj < 16; ++jj) { const int row0 = r_first + 2 * r_pair * (itb + jj); if (row0 >= r_end) break;
                const bool more = (jj + 1 < 16) && (row0 + 2 * r_pair < r_end);
                if (more) LN2_LOAD(jj + 1, xn, yan, ybn);
                float g0[2], g1[2]; bool ok[2];
#pragma unroll
                for (int q = 0; q < 2; ++q) { const int row = row0 + q * r_pair; ok[q] = row < r_end;
                    g0[q] = __uint_as_float(__builtin_amdgcn_readlane(__float_as_uint(gv), 4 * jj + 2 * q)); g1[q] = __uint_as_float(__builtin_amdgcn_readlane(__float_as_uint(gv), 4 * jj + 2 * q + 1)); }
                f32x4 v[2][4]; float s[2], s2[2];
#pragma unroll
                for (int q = 0; q < 2; ++q) { s[q] = 0.f;
#pragma unroll
                    for (int j = 0; j < 4; ++j) { const u32x2 x_ = xw[q][j];
                        const f32x2 a01 = __builtin_amdgcn_cvt_pk_f32_fp8((int)ya_[q][j], false), a23 = __builtin_amdgcn_cvt_pk_f32_fp8((int)ya_[q][j], true), b01 = __builtin_amdgcn_cvt_pk_f32_fp8((int)yb_[q][j], false), b23 = __builtin_amdgcn_cvt_pk_f32_fp8((int)yb_[q][j], true);
                        v[q][j][0] = ALPHA * bf_lo(x_.x) + (g0[q] * a01[0] + g1[q] * b01[0]); v[q][j][1] = ALPHA * bf_hi(x_.x) + (g0[q] * a01[1] + g1[q] * b01[1]);
                        v[q][j][2] = ALPHA * bf_lo(x_.y) + (g0[q] * a23[0] + g1[q] * b23[0]); v[q][j][3] = ALPHA * bf_hi(x_.y) + (g0[q] * a23[1] + g1[q] * b23[1]);
                        s[q] += (v[q][j][0] + v[q][j][1]) + (v[q][j][2] + v[q][j][3]); } }
                s[0] = wave_sum(s[0]); s[1] = wave_sum(s[1]);
#pragma unroll
                for (int q = 0; q < 2; ++q) { const float mean = s[q] * (1.f / D); s2[q] = 0.f;
#pragma unroll
                    for (int j = 0; j < 4; ++j) { v[q][j] = v[q][j] - mean; s2[q] += (v[q][j][0] * v[q][j][0] + v[q][j][1] * v[q][j][1]) + (v[q][j][2] * v[q][j][2] + v[q][j][3] * v[q][j][3]); } }
                s2[0] = wave_sum(s2[0]); s2[1] = wave_sum(s2[1]);
#pragma unroll
                for (int q = 0; q < 2; ++q) { if (!ok[q]) continue; const int row = row0 + q * r_pair;
                    const float rstd = 1.f / sqrtf(s2[q] * (1.f / D) + LN_EPS);
#pragma unroll
                    for (int j = 0; j < 4; ++j) { const f32x4 y = v[q][j] * rstd * gam[j] + bet[j];
                        if (l == DEPTH - 1) *(f32x4*)(fdst + (size_t)row * D + 256 * j + 4 * F.lane) = y;
                        else { u32x2 o; o.x = cvt_pk_bf16(y[0], y[1]); o.y = cvt_pk_bf16(y[2], y[3]); *(u32x2*)(xdst + (size_t)row * D + 256 * j + 4 * F.lane) = o;
                            if (!dummy) *(unsigned*)(ws + WS_XF8 + (size_t)row * D + 256 * j + 4 * F.lane) = pk4_fp8(y[0] * SX8, y[1] * SX8, y[2] * SX8, y[3] * SX8); } } }
                if (more) {
#pragma unroll
                    for (int q = 0; q < 2; ++q)
#pragma unroll
                        for (int j = 0; j < 4; ++j) { xw[q][j] = xn[q][j]; ya_[q][j] = yan[q][j]; yb_[q][j] = ybn[q][j]; } }
            }
#undef LN2_LOAD
            }
        }

__device__ __forceinline__ void xcd_barrier_work(const int wv, const bool want_local, const bool work) {
    const int tid_ = wv * 64 + lane_now();
    asm volatile("s_waitcnt vmcnt(0)" ::: "memory");
    __syncthreads();
    volatile LAS int* misc = (volatile LAS int*)((LAS unsigned char*)lds_raw + LC_MISC);
    XcdBarrier b; { kargp_t kq = (kargp_t)__builtin_amdgcn_kernarg_segment_ptr(); asm volatile("" : "+s"(kq)); b.bar = (unsigned*)(kq->ws + WS_CTL) + CW_BAR; b.x = xb_xcc_id(); b.st = (volatile LAS unsigned*)((LAS unsigned char*)lds_raw + LC_MISC) + 8; }
    const unsigned gen_expected = (unsigned)misc[LW_GEN] + 1u;
    __syncthreads();
    if (tid_ < 64) {
        if (tid_ == 0) {
            unsigned* bar = b.bar;
            __builtin_amdgcn_s_waitcnt(0);
            unsigned nloc = b.st[0], nx = b.st[1];
            if (nloc == 0u) { xcd_barrier_complete(bar, b.x, nloc, nx); b.st[0] = nloc; b.st[1] = nx;
                unsigned seen = 0u, okc = (gridDim.x == 256u) ? 1u : 0u;
#pragma unroll
                for (int c = 0; c < 8; ++c) { const unsigned m = xb_ld(&bar[CW_CLS - CW_BAR + c]); okc &= (m != 0u && (m & (m - 1u)) == 0u && (seen & m) == 0u) ? 1u : 0u; seen |= m; }
                b.st[2] = 1u + okc; }
            const bool local = want_local && (b.st[2] == 2u);
            if (local) {
                const unsigned lc = b.st[3] + 1u; b.st[3] = lc;
                (void)__hip_atomic_fetch_add(&bar[XB_XLOC(b.x)], 1u, __ATOMIC_RELAXED, __HIP_MEMORY_SCOPE_AGENT);
                asm volatile("buffer_inv sc1" ::: "memory");
                XB_SPIN(xb_ld(&bar[XB_XLOC(b.x)]) < lc * nloc, bar);
                asm volatile("s_waitcnt vmcnt(0)" ::: "memory");
            } else {
            const unsigned old = xb_add(&bar[XB_XSUB(b.x)], 1u);
            asm volatile("buffer_inv sc1" ::: "memory");
            const unsigned gen = old / nloc;
            if (old + 1u == (gen + 1u) * nloc) {
                if (!local) {
                __builtin_amdgcn_fence(__ATOMIC_RELEASE, "agent");
                asm volatile("s_waitcnt vmcnt(0)" ::: "memory");
                const unsigned og = xb_add(&bar[XB_TOP], 1u);
                const unsigned tg = og / nx;
                if (og + 1u == (tg + 1u) * nx) xb_add(&bar[XB_TOPGEN], 1u);
                else XB_SPIN(xb_ld(&bar[XB_TOPGEN]) == tg, bar);
                }
                xb_add(&bar[XB_XGEN(b.x)], 1u);
                asm volatile("s_waitcnt vmcnt(0)" ::: "memory");
            } else {
                XB_SPIN(xb_ld(&bar[XB_XGEN(b.x)]) == gen, bar);
                asm volatile("s_waitcnt vmcnt(0)" ::: "memory");
            }
            }
            misc[LW_REL] = (int)gen_expected;
        }
    } else {
        kargp_t kp = (kargp_t)__builtin_amdgcn_kernarg_segment_ptr(); asm volatile("" : "+s"(kp)); unsigned char* ws = kp->ws;
        const int lane = lane_now(), wave = wv;
        LAS float* scr = (LAS float*)((LAS unsigned char*)lds_raw + wave * 16384);
        bool more = (NREP(16) > 1) ? false : work;
        while (misc[LW_REL] != (int)gen_expected) {
            if (more) more = cq_step(kp, ws, scr, lane, QTOTAL);
            else __builtin_amdgcn_s_sleep(4);
        }
    }
    __syncthreads();
    if (tid_ == 0) misc[LW_GEN] = (int)gen_expected;
}
__device__ __forceinline__ void cq_drain(kargp_t kp, unsigned char* ws, int lmax, const int wv) {
    const int lane = lane_now(), wave = wv;
    LAS float* scr = (LAS float*)((LAS unsigned char*)lds_raw + wave * 16384);
    __syncthreads();
    while (cq_step(kp, ws, scr, lane, lmax * NPL)) {}
    __syncthreads();
}


__global__ void __launch_bounds__(NTHREADS, 2) fwd_kernel(Args args) {
    Frame F;
    F.lds = (LAS unsigned char*)lds_raw;
    const int wv0 = __builtin_amdgcn_readfirstlane(threadIdx.x >> 6);
    F.wave = wv0; F.lane = lane_now(); F.tid = wv0 * 64 + F.lane;
    F.G = gridDim.x; { const int bx = blockIdx.x; F.bid = bx; F.vcu = (F.G % 8 == 0) ? (bx % 8) * (F.G / 8) + bx / 8 : bx; }
    unsigned char* ws = args.ws;
    F.ctl = (gu32*)(ws + WS_CTL);
    for (int u = F.tid; u < (LDS_BYTES - LC_OFF) / 4; u += NTHREADS) ((LAS unsigned*)(F.lds + LC_OFF))[u] = 0u;
    __syncthreads();
    if (F.tid == 0) ((LAS int*)(F.lds + LC_MISC))[LW_Q] = QB;
    __syncthreads();
#if MK_ONE_LAUNCH
    if (F.tid == 0) { (void)__hip_atomic_fetch_or(F.ctl + CW_CLS + (F.bid & 7), 1u << xb_xcc_id(), __ATOMIC_RELAXED, __HIP_MEMORY_SCOPE_AGENT); asm volatile("s_waitcnt vmcnt(0)" ::: "memory"); }
    (void)xcd_barrier_post((unsigned*)(F.ctl + CW_BAR), (volatile LAS unsigned*)(F.lds + LC_MISC) + 8);
#define GRID_BAR() xcd_barrier_work(wv0, false, true)
#define XCD_BAR() xcd_barrier_work(wv0, true, true)
#define XCD_BAR_NW() xcd_barrier_work(wv0, true, false)
#else
#define GRID_BAR() do {} while (0)
#define XCD_BAR() do {} while (0)
#define XCD_BAR_NW() do {} while (0)
#endif
    kargp_t kp = (kargp_t)__builtin_amdgcn_kernarg_segment_ptr();
    const int lo = args.ph_lo, hi = args.ph_hi; (void)ws;
#ifndef PH_MASK
#define PH_MASK 0x1ff
#endif
#define IN(k) (lo <= (k) && (k) < hi)
#define EN(p) ((PH_MASK >> (p)) & 1)

#define FRESH() do { F.wave = wv0; F.lane = lane_now(); F.tid = wv0 * 64 + F.lane; { int bx_ = blockIdx.x; asm volatile("" : "+s"(bx_)); F.bid = bx_; } \
        kp = (kargp_t)__builtin_amdgcn_kernarg_segment_ptr(); asm volatile("" : "+s"(kp)); ws = kp->ws; F.ctl = (gu32*)(ws + WS_CTL); } while (0)
#define SEAM(k) do { if (IN(k) && IN((k) + 1)) GRID_BAR(); } while (0)
#define SEAM_W(k, w) do { if (IN(k) && IN((k) + 1)) xcd_barrier_work(wv0, false, (w)); } while (0)
#define SEAM_LW(k, w) do { if (IN(k) && IN((k) + 1)) xcd_barrier_work(wv0, true, (w)); } while (0)
#define SEAM_LN(k) do { if (IN(k) && IN((k) + 1)) XCD_BAR_NW(); } while (0)
#define SEAM_L(k) do { if (IN(k) && IN((k) + 1)) XCD_BAR(); } while (0)

    if (EN(8) && IN(0)) for (int rep_ = 0; rep_ < NREP(8); ++rep_) { phase_prologue(wv0); }
#if MK_ONE_LAUNCH
    SEAM_W(0, false);
#else
    SEAM(0);
#endif

    for (int l = 0; l < DEPTH; ++l) {
        const int pb = 1 + 8 * l;
        if (EN(0) && IN(pb + 0)) for (int rep_ = 0; rep_ < (NREP(0) > NREP(11) ? NREP(0) : NREP(11)); ++rep_) { FRESH();
            pg8::SchedStatic S{(const char*)(ws + WS_XF8), (const char*)(ws + WS_WIN) + (size_t)l * NIN * D, T / 256, NIN / 256, F.G, F.bid, (size_t)256 * D};
            pg8::EpiProj E{proj, bias_s + l * NIN, (NREP(11) > 1 && rep_ == 0) ? 1 : 0, (unsigned char*)(ws + WS_GATE)};
            pg8::gemm_phase<D / 2, false, pg8::EpiProj, pg8::SchedStatic, false, true>(F.lds, F.tid, S, E, E_X8, E_W8);
        }
#if MK_ONE_LAUNCH
        { const int nwg_ = (T / 256) * (NIN / 256); int bx_ = blockIdx.x; asm volatile("" : "+s"(bx_)); SEAM_LW(pb + 0, bx_ >= nwg_ - (nwg_ / (int)gridDim.x) * (int)gridDim.x); }
#else
        SEAM_L(pb + 0);
#endif
        if (EN(1) && IN(pb + 1)) for (int rep_ = 0; rep_ < NREP(1); ++rep_) {
            phase_attn_mfma(l, wv0);
        }
        SEAM_LN(pb + 1);
        if (EN(2) && IN(pb + 2)) for (int rep_ = 0; rep_ < (NREP(2) > NREP(12) ? NREP(2) : NREP(12)); ++rep_) { FRESH();
            pg8::SchedTwoSeg S{(const char*)(ws + WS_YA), (long)(16 * MiB), (const char*)(ws + WS_WA) + (size_t)l * D * 512, (long)(WS_WB - WS_WA), T / 256, D / 256, F.G, F.bid, (size_t)256 * 512};
            pg8::EpiMerge E{(unsigned char*)(ws + WS_MERGED), (const unsigned char*)(ws + WS_GATE), (NREP(12) > 1 && rep_ == 0) ? 1 : 0};
            pg8::gemm_phase<D / 2, false, pg8::EpiMerge, pg8::SchedTwoSeg, true, true>(F.lds, F.tid, S, E, E_Y8, E_W8);
        }
        SEAM_LN(pb + 2);
        if (EN(3) && IN(pb + 3)) for (int rep_ = 0; rep_ < NREP(3); ++rep_) { FRESH();
            pg8::SchedStatic S{(const char*)(ws + WS_MERGED), (const char*)(ws + WS_WO) + (size_t)l * D * D, T / 256, D / 256, F.G, F.bid, (size_t)256 * D};
            pg8::EpiPlain8 E{(unsigned char*)mix, D, SMX8};
            pg8::gemm_phase<D / 2, false, pg8::EpiPlain8, pg8::SchedStatic, false, true>(F.lds, F.tid, S, E, E_M8, E_W8);
        }
        SEAM_LN(pb + 3);
        if (EN(4) && IN(pb + 4)) { phase_ln1(l, false, wv0); }
#if MK_ONE_LAUNCH
        SEAM_W(pb + 4, false);
#else
        SEAM(pb + 4);
#endif
        if (EN(5) && IN(pb + 5)) for (int rep_ = 0; rep_ < NREP(5); ++rep_) { FRESH();
            const int ntiles = moe_tables(F, l);
            pg8::SchedMoe S{(const char*)(ws + WS_XF8), (const char*)(ws + WS_WGU) + (size_t)l * NE * 1024 * D, tok, (const LAS int*)(F.lds + LC_T2E), (const LAS int*)(F.lds + LC_TSTART), (const LAS int*)(F.lds + LC_CNT), ntiles, F.G, F.vcu,
                            0, (size_t)1024 * D, (size_t)256 * D, D};
            pg8::EpiSwiglu E{(unsigned char*)(ws + WS_H)};
            pg8::gemm_phase<D / 2, true, pg8::EpiSwiglu, pg8::SchedMoe, false, true>(F.lds, F.tid, S, E, E_X8, E_W8);
        }
        SEAM_LN(pb + 5);
        if (EN(6) && IN(pb + 6)) for (int rep_ = 0; rep_ < NREP(6); ++rep_) { FRESH();
            const int ntiles = moe_tables_cached(F, l);
            pg8::SchedMoe S{(const char*)(ws + WS_H), (const char*)(ws + WS_WD) + (size_t)l * NE * D * DE, tok, (const LAS int*)(F.lds + LC_T2E), (const LAS int*)(F.lds + LC_TSTART), (const LAS int*)(F.lds + LC_CNT), ntiles, F.G, F.vcu,
                            (size_t)256 * DE, (size_t)D * DE, (size_t)256 * DE, DE};
            pg8::EpiPlain8 E{(unsigned char*)(ws + WS_Y2), D, SY28};
            pg8::gemm_phase<DE / 2, false, pg8::EpiPlain8, pg8::SchedMoe, false, true>(F.lds, F.tid, S, E, E_H8, E_W8);
        }
#if MK_ONE_LAUNCH
        if (EN(6) && IN(pb + 6) && l + 1 < DEPTH) { FRESH(); cq_drain(kp, ws, l + 1, wv0); }
#endif
#if MK_ONE_LAUNCH
        { const int U_ = 4 * __builtin_amdgcn_readfirstlane(((const LAS int*)((LAS unsigned char*)lds_raw + LC_TSTART))[NE]); const int G_ = (int)gridDim.x; int bx_ = blockIdx.x; asm volatile("" : "+s"(bx_));
          const int vcu_ = (G_ % 8 == 0) ? (bx_ % 8) * (G_ / 8) + bx_ / 8 : bx_; const int rem_ = U_ % G_; SEAM_W(pb + 6, rem_ != 0 && vcu_ >= rem_); }
#else
        SEAM(pb + 6);
#endif
        if (EN(7) && IN(pb + 7)) { phase_ln2(l, false, wv0); }
        SEAM_LN(pb + 7);
    }
#undef IN
#undef SEAM
}


extern "C" void kernel_launch(void* const* d_in, const int* in_sizes, int n_in, void* d_out, int out_size, void* d_ws, size_t ws_size, hipStream_t stream) {
    static int grid = 0;
    if (grid == 0) {
        if (n_in != 16 || in_sizes[0] != T * D || out_size != T * D || ws_size < WS_END) { fprintf(stderr, "kernel_launch: unexpected shapes (n_in %d, in0 %d, out %d, ws %zu < %zu)\n", n_in, n_in > 0 ? in_sizes[0] : -1, out_size, ws_size, (size_t)WS_END); grid = -1; return; }
        int dev = 0, cus = 0, per_cu = 0;
        if (hipGetDevice(&dev) != hipSuccess || hipDeviceGetAttribute(&cus, hipDeviceAttributeMultiprocessorCount, dev) != hipSuccess) { grid = -1; return; }
        if (hipFuncSetAttribute((const void*)fwd_kernel, hipFuncAttributeMaxDynamicSharedMemorySize, LDS_BYTES) != hipSuccess) { fprintf(stderr, "kernel_launch: hipFuncSetAttribute failed\n"); grid = -1; return; }
        if (hipOccupancyMaxActiveBlocksPerMultiprocessor(&per_cu, (const void*)fwd_kernel, NTHREADS, LDS_BYTES) != hipSuccess || per_cu < 1) fprintf(stderr, "kernel_launch: occupancy query reports %d\n", per_cu);
        (void)hipGetLastError();
        grid = cus;
    }
    if (grid < 0) return;
    (void)hipMemsetAsync((char*)d_ws + WS_CTL, 0, CTL_ZERO_BYTES, stream);
    Args a{};
    for (int i = 0; i < 16; ++i) a.in[i] = (const float*)d_in[i];
    a.out = (float*)d_out; a.ws = (unsigned char*)d_ws;
#if MK_ONE_LAUNCH
    a.ph_lo = 0; a.ph_hi = N_PHASES;
    hipLaunchKernelGGL(fwd_kernel, dim3(grid), dim3(NTHREADS), LDS_BYTES, stream, a);
#else
    for (int p = 0; p < N_PHASES; ++p) { a.ph_lo = p; a.ph_hi = p + 1; hipLaunchKernelGGL(fwd_kernel, dim3(grid), dim3(NTHREADS), LDS_BYTES, stream, a);
    }
#endif
}
```

```cpp
#include <hip/hip_runtime.h>
#include <cstdio>
#include <cstdint>

#ifndef MK_ONE_LAUNCH
#define MK_ONE_LAUNCH 1
#endif
#ifndef DIAG
#define DIAG 0
#define REP_MASK 0x000
#define NREP(p) (((REP_MASK >> (p)) & 1) ? 2 : 1)
#endif

#define LAS __attribute__((address_space(3)))
#define GAS __attribute__((address_space(1)))
typedef unsigned short bf16_t;
typedef short bf16x8 __attribute__((ext_vector_type(8)));
typedef float f32x4 __attribute__((ext_vector_type(4)));
typedef float f32x2 __attribute__((ext_vector_type(2)));
typedef unsigned u32x4 __attribute__((ext_vector_type(4)));
typedef unsigned u32x2 __attribute__((ext_vector_type(2)));
typedef GAS unsigned gu32;

constexpr int D = 1024, BATCH = 16, SEQ = 2048, T = BATCH * SEQ, DEPTH = 4;
constexpr int NIN = 4352, NE = 32, DE = 512;
constexpr int PP = 2304;
constexpr int C_AQ = 0, C_AK = 512, C_AV = 640, C_SQ = 768, C_SK = 1280, C_SV = 1792, C_GA = 2304, C_GB = 3328;
constexpr float LN_EPS = 1e-5f;
constexpr float ALPHA = 1.6817928305074290f;
constexpr float LOG2E = 1.4426950408889634f;
constexpr float C2 = 0.125f * LOG2E;
constexpr int TOKCAP = T;
constexpr int MAXTILES = T * 2 / 256 + NE;

constexpr size_t MiB = 1u << 20;
constexpr size_t WS_CTL = 0, CTL_ZERO_BYTES = 1 * MiB;
constexpr size_t WS_BIAS = 1 * MiB;
constexpr size_t WS_WIN = 2 * MiB;
constexpr size_t WS_WA = 36 * MiB, WS_WB = 40 * MiB;
constexpr size_t WS_WO = 44 * MiB;
constexpr size_t WS_WGU = 52 * MiB;
constexpr size_t WS_WD = 308 * MiB;
constexpr size_t WS_XB = 436 * MiB;
constexpr size_t WS_PROJ = 500 * MiB;
constexpr size_t WS_GATE = 644 * MiB;
constexpr size_t WS_H = 500 * MiB;
constexpr size_t WS_Y2 = 906 * MiB;
constexpr size_t WS_YA = 772 * MiB, WS_YB = 804 * MiB;
constexpr size_t WS_MIX = 180 * MiB;
constexpr size_t WS_MERGED = 836 * MiB;
constexpr size_t WS_XF8 = WS_MERGED + 32 * MiB;
constexpr float SMX8 = 32.f;
constexpr float SX8 = 8.f, SW8 = 64.f, SY8 = 64.f, SM8 = 128.f, SH8 = 16.f, SG8 = 256.f, SY28 = 128.f;
constexpr int E_X8 = 0x01010101 * (127 - 3), E_W8 = 0x01010101 * (127 - 6), E_Y8 = 0x01010101 * (127 - 6), E_M8 = 0x01010101 * (127 - 7), E_H8 = 0x01010101 * (127 - 4);
constexpr size_t WS_TOK = 900 * MiB;
constexpr size_t WS_SLOT = 904 * MiB;
constexpr size_t WS_END = 978 * MiB;
static_assert(WS_WIN + (size_t)DEPTH * NIN * D * 2 <= WS_WA && WS_WGU + (size_t)DEPTH * NE * 1024 * D * 2 <= WS_WD && WS_WD + (size_t)DEPTH * NE * D * 512 * 2 <= WS_XB, "ws map");
static_assert(WS_Y2 + (size_t)MAXTILES * 256 * D <= WS_END && WS_PROJ + (size_t)T * PP * 2 <= WS_GATE && WS_GATE + (size_t)2 * T * D * 2 <= WS_YA && WS_H + (size_t)MAXTILES * 256 * 512 * 2 <= WS_Y2 && WS_WGU + (size_t)DEPTH * NE * 1024 * D <= WS_MIX && WS_MIX + (size_t)T * D * 2 <= WS_WD && WS_H + (size_t)MAXTILES * 256 * 512 <= WS_GATE, "ws map 2");
constexpr int CW_CLS = 8192;
constexpr int CW_TMO = 0, CW_CODE = 1, CW_BAR = 4096, CW_CNT = 16384;

constexpr int RING_BYTES = 131072;
constexpr int LC_OFF = 132096;
constexpr int LC_MISC = LC_OFF + 0;
constexpr int LC_HIST = LC_OFF + 256, LC_BASE = LC_OFF + 384, LC_CNT = LC_OFF + 512, LC_TSTART = LC_OFF + 704;
constexpr int LC_T2E = LC_OFF + 1024;
constexpr int LC_SE = LC_OFF + 2560, LC_SR = LC_SE + 1024, LC_SG = LC_SR + 1024;
constexpr int LC_LOGIT = LC_OFF + 5632;
constexpr int LC_GB = LC_OFF + 22528;
constexpr int LC_RB = LC_GB + 8192;
constexpr int LDS_BYTES = LC_RB + 128;
static_assert(LC_SG + 1024 <= LC_LOGIT && LC_LOGIT + 128 * 33 * 4 <= LC_GB && LDS_BYTES <= 160 * 1024 && LC_T2E + MAXTILES * 4 <= LC_SE && 32 * 1028 * 4 <= LC_OFF, "LDS map");

constexpr int NWAVES = 8, NTHREADS = 512;

__device__ __forceinline__ unsigned cvt_pk_bf16(float lo, float hi) { unsigned r; asm volatile("v_cvt_pk_bf16_f32 %0, %1, %2" : "=v"(r) : "v"(lo), "v"(hi)); return r; }
__device__ __forceinline__ float bf_lo(unsigned u) { return __uint_as_float(u << 16); }
__device__ __forceinline__ float bf_hi(unsigned u) { return __uint_as_float(u & 0xffff0000u); }
__device__ __forceinline__ int lane_now() { int l_; asm volatile("v_mbcnt_lo_u32_b32 %0, -1, 0\n\tv_mbcnt_hi_u32_b32 %0, -1, %0" : "=v"(l_)); return l_; }
__device__ __forceinline__ unsigned pk4_fp8(float a, float b, float c, float d) {
    int w = __builtin_amdgcn_cvt_pk_fp8_f32(a, b, 0, false); w = __builtin_amdgcn_cvt_pk_fp8_f32(c, d, w, true); return (unsigned)w; }
__device__ __forceinline__ float wave_sum(float x) {
    x += __int_as_float(__builtin_amdgcn_update_dpp(0, __float_as_int(x), 0xB1, 0xf, 0xf, false));
    x += __int_as_float(__builtin_amdgcn_update_dpp(0, __float_as_int(x), 0x4E, 0xf, 0xf, false));
    x += __int_as_float(__builtin_amdgcn_update_dpp(0, __float_as_int(x), 0x141, 0xf, 0xf, false));
    x += __int_as_float(__builtin_amdgcn_update_dpp(0, __float_as_int(x), 0x140, 0xf, 0xf, false));
    { const unsigned u = __float_as_uint(x); auto r = __builtin_amdgcn_permlane16_swap(u, u, false, false); x = __uint_as_float(r[0]) + __uint_as_float(r[1]); }
    { const unsigned u = __float_as_uint(x); auto r = __builtin_amdgcn_permlane32_swap(u, u, false, false); x = __uint_as_float(r[0]) + __uint_as_float(r[1]); }
    return x;
}
__device__ __forceinline__ float shx(float v, int o, int lane) { return __int_as_float(__builtin_amdgcn_ds_bpermute((lane ^ o) << 2, __float_as_int(v))); }
__device__ __forceinline__ float fast_exp2(float x) { return __builtin_amdgcn_exp2f(x); }
__device__ __forceinline__ float fast_rcp(float x) { return __builtin_amdgcn_rcpf(x); }
__device__ __forceinline__ float sigmoidf_(float x) { return 1.0f / (1.0f + __expf(-x)); }

#define XB_TMO      128
#define XB_XCNT(j)  (256  + 64 * (j))
#define XB_XSUB(j)  (1280 + 64 * (j))
#define XB_XGEN(j)  (2304 + 64 * (j))
#define XB_XLOC(j)  (4160 + 64 * (j))
#define XB_TOP      3328
#define XB_TOPGEN   3392
#define XCD_BAR_WORDS 3456
#define XB_SPIN_CAP (1u << 18)
__device__ __forceinline__ unsigned xb_ld(unsigned* p)              { return __hip_atomic_load(p, __ATOMIC_RELAXED, __HIP_MEMORY_SCOPE_AGENT); }
__device__ __forceinline__ unsigned xb_add(unsigned* p, unsigned v) { return __hip_atomic_fetch_add(p, v, __ATOMIC_RELAXED, __HIP_MEMORY_SCOPE_AGENT); }
__device__ __forceinline__ unsigned xb_xcc_id() { return (unsigned)__builtin_amdgcn_s_getreg((3 << 11) | 20) & 0xFu; }
#define XB_SPIN(cond, bar) do { unsigned _sp = 0; while (cond) { __builtin_amdgcn_s_sleep(1); \
    if ((++_sp & 255u) == 0u) { if (xb_ld(&(bar)[XB_TMO])) break; if (_sp > XB_SPIN_CAP) { atomicAdd(&(bar)[XB_TMO], 1u); break; } } } } while (0)
struct XcdBarrier { unsigned* bar; unsigned x; volatile LAS unsigned* st; };
__device__ __forceinline__ XcdBarrier xcd_barrier_post(unsigned* bar, volatile LAS unsigned* st) {
    XcdBarrier b; b.bar = bar; b.x = xb_xcc_id(); b.st = st;
    if (threadIdx.x == 0) (void)xb_add(&bar[XB_XCNT(b.x)], 1u);
    return b;
}
__device__ __forceinline__ void xcd_barrier_complete(unsigned* bar, unsigned x, unsigned& nloc, unsigned& nx) {
    const unsigned G = gridDim.x * gridDim.y * gridDim.z;
    unsigned sum, cnt, mine, sp = 0u;
    for (;;) {
        sum = 0u; cnt = 0u; mine = 0u;
#pragma unroll
        for (unsigned j = 0; j < 16; ++j) { const unsigned c = xb_ld(&bar[XB_XCNT(j)]); sum += c; cnt += (c > 0u) ? 1u : 0u; mine = (j == x) ? c : mine; }
        if (sum == G) break;
        __builtin_amdgcn_s_sleep(1);
        if ((++sp & 255u) == 0u) { if (xb_ld(&bar[XB_TMO])) break; if (sp > XB_SPIN_CAP) { atomicAdd(&bar[XB_TMO], 1u); break; } }
    }
    nloc = mine > 0u ? mine : 1u; nx = cnt > 0u ? cnt : 1u;
}
__device__ __forceinline__ void xcd_barrier(const XcdBarrier& b) {
    asm volatile("s_waitcnt vmcnt(0)" ::: "memory");
    __syncthreads();
    if (threadIdx.x == 0) {
        unsigned* bar = b.bar;
        __builtin_amdgcn_s_waitcnt(0);
        unsigned nloc = b.st[0], nx = b.st[1];
        if (nloc == 0u) { xcd_barrier_complete(bar, b.x, nloc, nx); b.st[0] = nloc; b.st[1] = nx; }
        const unsigned old = xb_add(&bar[XB_XSUB(b.x)], 1u);
        const unsigned gen = old / nloc;
        if (old + 1u == (gen + 1u) * nloc) {
            __builtin_amdgcn_fence(__ATOMIC_RELEASE, "agent");
            asm volatile("s_waitcnt vmcnt(0)" ::: "memory");
            const unsigned og = xb_add(&bar[XB_TOP], 1u);
            const unsigned tg = og / nx;
            if (og + 1u == (tg + 1u) * nx) xb_add(&bar[XB_TOPGEN], 1u);
            else XB_SPIN(xb_ld(&bar[XB_TOPGEN]) == tg, bar);
            __builtin_amdgcn_fence(__ATOMIC_ACQUIRE, "agent");
            xb_add(&bar[XB_XGEN(b.x)], 1u);
            asm volatile("s_waitcnt vmcnt(0)" ::: "memory");
        } else {
            XB_SPIN(xb_ld(&bar[XB_XGEN(b.x)]) == gen, bar);
            __builtin_amdgcn_fence(__ATOMIC_ACQUIRE, "agent");
            asm volatile("s_waitcnt vmcnt(0)" ::: "memory");
        }
    }
    __syncthreads();
}

namespace pg8 {
constexpr int BM = 256, BK = 64, HALF = 128, HTB = HALF * BK * 2, STAGE_BYTES = 8 * HTB, NXCD = 8, WGM = 8;
__host__ __device__ __forceinline__ int lds_byte(int r, int c) { const int st = (r >> 4) * 2 + (c >> 5), rr = r & 15, cc = c & 31, ob = rr * 64 + cc * 2; return st * 1024 + (ob ^ (((ob >> 9) & 1) << 5)); }
__host__ __device__ __forceinline__ void stage_rc(int b, int& R, int& C) { const int st = b / 1024, sb = b % 1024, swz = sb ^ (((sb >> 9) & 1) << 5); R = (st >> 1) * 16 + swz / 64; C = (st & 1) * 32 + (swz % 64) / 2; }
__host__ __device__ __forceinline__ int perm32(int rho) { const int n = rho >> 4, i = rho & 15; return 8 * (i >> 2) + 4 * n + (i & 3); }

struct Unit { int pm, pn, aux; };

__device__ __forceinline__ bool static_tile(int nM, int nN, int G, int c, int i, int& pm, int& pn) {
    const int nwg = nM * nN; const long L = (long)i * G + c; if (L >= nwg) return false;
    int wgid = (int)L; { const int q = nwg / NXCD, r = nwg % NXCD, xcd = wgid % NXCD, off = wgid / NXCD; wgid = (xcd < r ? xcd * (q + 1) : r * (q + 1) + (xcd - r) * q) + off; }
    const int nig = WGM * nN, gid = wgid / nig, fm = gid * WGM, gsz = (nM - fm) < WGM ? (nM - fm) : WGM;
    pm = fm + ((wgid % nig) % gsz); pn = (wgid % nig) / gsz; return true;
}

template <int K, bool GATHER, class Epi, class Sched, bool TWOSEG = false, bool FP8 = false>
__device__ __forceinline__ void gemm_phase(LAS unsigned char* lds, const int tid, const Sched& S, const Epi& E, const int sc_a = 0x7f7f7f7f, const int sc_b = 0x7f7f7f7f) {
    const int wid = __builtin_amdgcn_readfirstlane(tid >> 6), lane = tid & 63, wr = wid >> 2, wc = wid & 3, fr = lane & 15, fq = lane >> 4;
    constexpr int nt = K / BK;
    constexpr int LD = TWOSEG ? K / 2 : K;
    static_assert(K % 128 == 0 && K >= 256 && (!TWOSEG || (nt % 4 == 0 && !GATHER)), "K");
    int Rr[2], Cc[2]; unsigned voffB[2];
#pragma unroll
    for (int i = 0; i < 2; ++i) { int R, C; stage_rc(tid * 16 + i * 8192, R, C); const int Rb = (R & ~31) + perm32(R & 31); Rr[i] = R; Cc[i] = C; voffB[i] = (unsigned)(Rb * LD + C) * 2u; }
    constexpr size_t kstep = (size_t)(BK * 2);
    constexpr size_t hstepB = (size_t)HALF * LD * 2;
    constexpr size_t hstepA = GATHER ? 0 : (size_t)HALF * LD * 2;
    const unsigned ldsw = (unsigned)wid * 1024u; const unsigned ldsbase = (unsigned)(uintptr_t)lds;
    const int aoff = lds_byte(wr * 64 + fr, fq * 8), boff = lds_byte(wc * 32 + fr, fq * 8);
#define PG8_SA(b, h) (((b) * 2 + (h)) * HTB)
#define PG8_SB(b, h) ((4 + (b) * 2 + (h)) * HTB)
#define PG8_STAGE(bufoff, gbase, voff) do { _Pragma("unroll") for (int _i = 0; _i < 2; ++_i) { \
        if constexpr (FP8 || GATHER) { unsigned keep_; asm volatile("s_mov_b32 %0, m0\n\ts_mov_b32 m0, %3\n\ts_nop 0\n\tglobal_load_lds_dwordx4 %1, %2\n\ts_mov_b32 m0, %0" : "=&s"(keep_) : "v"((voff)[_i]), "s"((const char*)(gbase)), \
                     "s"((unsigned)__builtin_amdgcn_readfirstlane((int)(ldsbase + (unsigned)(bufoff) + ldsw + _i * 8192u))) : "memory"); } \
        else __builtin_amdgcn_global_load_lds((const unsigned*)((const char*)(gbase) + (voff)[_i]), (LAS unsigned*)(lds + (bufoff) + ldsw + _i * 8192), 16, 0, 0); } } while (0)
    typedef int v8i_ __attribute__((ext_vector_type(8))); typedef int v4i_ __attribute__((ext_vector_type(4)));
#define PG8_LDA(dst, b, h) do { _Pragma("unroll") for (int m = 0; m < 4; ++m) { \
        if constexpr (FP8) { const v4i_ lo_ = *(const LAS v4i_*)(lds + PG8_SA(b, h) + aoff + m * 2048), hi_ = *(const LAS v4i_*)(lds + PG8_SA(b, h) + aoff + m * 2048 + 1024); dst##8[m] = __builtin_shufflevector(lo_, hi_, 0, 1, 2, 3, 4, 5, 6, 7); } \
        else { _Pragma("unroll") for (int k = 0; k < 2; ++k) dst[m][k] = *(const LAS bf16x8*)(lds + PG8_SA(b, h) + aoff + m * 2048 + k * 1024); } } } while (0)
#define PG8_LDB(dst, b, h) do { _Pragma("unroll") for (int n = 0; n < 2; ++n) { \
        if constexpr (FP8) { const v4i_ lo_ = *(const LAS v4i_*)(lds + PG8_SB(b, h) + boff + n * 2048), hi_ = *(const LAS v4i_*)(lds + PG8_SB(b, h) + boff + n * 2048 + 1024); dst##8[n] = __builtin_shufflevector(lo_, hi_, 0, 1, 2, 3, 4, 5, 6, 7); } \
        else { _Pragma("unroll") for (int k = 0; k < 2; ++k) dst[n][k] = *(const LAS bf16x8*)(lds + PG8_SB(b, h) + boff + n * 2048 + k * 1024); } } } while (0)
#define PG8_MMA(ai, bj, At, Bt) do { __builtin_amdgcn_s_setprio(1); _Pragma("unroll") for (int m = 0; m < 4; ++m) _Pragma("unroll") for (int n = 0; n < 2; ++n) { \
        if constexpr (FP8) acc[ai][bj][m][n] = __builtin_amdgcn_mfma_scale_f32_16x16x128_f8f6f4(Bt##8[n], At##8[m], acc[ai][bj][m][n], 0, 0, 0, sc_b, 0, sc_a); \
        else { _Pragma("unroll") for (int k = 0; k < 2; ++k) acc[ai][bj][m][n] = __builtin_amdgcn_mfma_f32_16x16x32_bf16(Bt[n][k], At[m][k], acc[ai][bj][m][n], 0, 0, 0); } } \
        __builtin_amdgcn_s_setprio(0); } while (0)
#define PG8_WAIT_V(n) asm volatile("s_waitcnt vmcnt(" #n ")" ::: "memory")
#define PG8_WAIT_L(n) asm volatile("s_waitcnt lgkmcnt(" #n ")" ::: "memory")
#define PG8_BAR __builtin_amdgcn_s_barrier()
#define PG8_SCHED __builtin_amdgcn_sched_barrier(0)
    Unit cur, nxt; int ui = 0;
    if (!S.next(0, cur)) return;
    unsigned voffA[2][2], nvoffA[2][2];
    if constexpr (GATHER) {
        S.gather_issue(cur, Rr, voffA);
        asm volatile("s_waitcnt vmcnt(0)" : "+v"(voffA[0][0]), "+v"(voffA[0][1]), "+v"(voffA[1][0]), "+v"(voffA[1][1]) :: "memory");
#pragma unroll
        for (int h = 0; h < 2; ++h)
#pragma unroll
            for (int i = 0; i < 2; ++i) voffA[h][i] = S.gather_finish(voffA[h][i], Cc[i]);
    }
    else {
#pragma unroll
        for (int h = 0; h < 2; ++h)
#pragma unroll
            for (int i = 0; i < 2; ++i) voffA[h][i] = (unsigned)(Rr[i] * LD + Cc[i]) * 2u;
    }
    f32x4 acc[2][2][4][2];
#pragma unroll
    for (int a = 0; a < 2; ++a)
#pragma unroll
        for (int b = 0; b < 2; ++b)
#pragma unroll
            for (int m = 0; m < 4; ++m)
#pragma unroll
                for (int n = 0; n < 2; ++n) { f32x4 z_; asm volatile("v_mov_b32 %0, 0\n\tv_mov_b32 %1, 0\n\tv_mov_b32 %2, 0\n\tv_mov_b32 %3, 0" : "=v"(z_[0]), "=v"(z_[1]), "=v"(z_[2]), "=v"(z_[3])); acc[a][b][m][n] = z_; }
    const char* cA = S.abase(cur); const char* cB = S.bbase(cur);
    PG8_STAGE(PG8_SB(0, 0), cB, voffB); PG8_STAGE(PG8_SB(0, 1), cB + hstepB, voffB); PG8_STAGE(PG8_SA(0, 0), cA, voffA[0]); PG8_STAGE(PG8_SA(0, 1), cA + hstepA, voffA[1]);
    if (wr == 1) PG8_BAR;
    PG8_WAIT_V(2); PG8_BAR;
    PG8_STAGE(PG8_SB(1, 0), cB + kstep, voffB); PG8_STAGE(PG8_SA(1, 0), cA + kstep, voffA[0]); PG8_STAGE(PG8_SB(1, 1), cB + hstepB + kstep, voffB);
    PG8_WAIT_V(6); PG8_BAR;
    for (;;) {
        const bool has_next = S.next(ui + 1, nxt);
        const char* nA = has_next ? S.abase(nxt) : cA; const char* nB = has_next ? S.bbase(nxt) : cB;
        if constexpr (GATHER) {
            if (has_next) S.gather_issue(nxt, Rr, nvoffA);
        }
#pragma unroll 1
        for (int t = 0; t < nt; t += 2) {
            const bool last = (t == nt - 2);
            bf16x8 At[4][2], B0[2][2], B1[2][2]; v8i_ At8[4], B08[2], B18[2];
            (void)At; (void)B0; (void)B1; (void)At8; (void)B08; (void)B18;
            long sA1 = 0, sA2 = 0, sB2 = 0;
            if constexpr (TWOSEG) { if (t + 1 >= nt / 2) sA1 = S.adiff - (long)(nt / 2) * (long)kstep; if (t + 2 >= nt / 2) { sA2 = S.adiff - (long)(nt / 2) * (long)kstep; sB2 = S.bdiff - (long)(nt / 2) * (long)kstep; } }
            const char* a1 = cA + (size_t)(t + 1) * kstep + sA1;
            const char* a2 = last ? nA : cA + (size_t)(t + 2) * kstep + sA2; const char* b2 = last ? nB : cB + (size_t)(t + 2) * kstep + sB2;
            const char* a3 = a2 + kstep; const char* b3 = b2 + kstep;
            PG8_LDB(B0, 0, 0); PG8_LDB(B1, 0, 1); PG8_SCHED; PG8_LDA(At, 0, 0); PG8_STAGE(PG8_SA(1, 1), a1 + hstepA, voffA[1]);
            if constexpr (GATHER) { if (last) {
#pragma unroll
                for (int h = 0; h < 2; ++h)
#pragma unroll
                    for (int i = 0; i < 2; ++i) { if (has_next) voffA[h][i] = S.gather_finish(nvoffA[h][i], Cc[i]); }
            } }
            PG8_WAIT_V(8); PG8_WAIT_L(0); PG8_BAR; PG8_MMA(0, 0, At, B0); PG8_MMA(0, 1, At, B1); PG8_BAR; PG8_SCHED;
            PG8_LDA(At, 0, 1); PG8_STAGE(PG8_SB(0, 0), b2, voffB); PG8_STAGE(PG8_SB(0, 1), b2 + hstepB, voffB); PG8_STAGE(PG8_SA(0, 0), a2, voffA[0]);
            PG8_WAIT_V(8); PG8_WAIT_L(0); PG8_BAR; PG8_MMA(1, 0, At, B0); PG8_MMA(1, 1, At, B1); PG8_BAR; PG8_SCHED;
            PG8_LDB(B0, 1, 0); PG8_LDB(B1, 1, 1); PG8_SCHED; PG8_LDA(At, 1, 0); PG8_STAGE(PG8_SA(0, 1), a2 + hstepA, voffA[1]);
            PG8_WAIT_V(8); PG8_WAIT_L(0); PG8_BAR; PG8_MMA(0, 0, At, B0); PG8_MMA(0, 1, At, B1); PG8_BAR; PG8_SCHED;
            PG8_LDA(At, 1, 1); PG8_STAGE(PG8_SB(1, 0), b3, voffB); PG8_STAGE(PG8_SB(1, 1), b3 + hstepB, voffB); PG8_STAGE(PG8_SA(1, 0), a3, voffA[0]);
            PG8_WAIT_V(8); PG8_WAIT_L(0); PG8_BAR; PG8_MMA(1, 0, At, B0); PG8_MMA(1, 1, At, B1); PG8_BAR; PG8_SCHED;
            if constexpr (TWOSEG) { if (t == nt / 2 - 2) { const int l2_ = lane_now(); E.mid(acc, cur, wr, wc, l2_ & 15, l2_ >> 4); } }
        }
        if (wr == 0) PG8_BAR;
        { const int l2_ = lane_now(); E(acc, cur, wr, wc, l2_ & 15, l2_ >> 4); }
        if (!has_next) break;
#pragma unroll
        for (int a = 0; a < 2; ++a)
#pragma unroll
            for (int b = 0; b < 2; ++b)
#pragma unroll
                for (int m = 0; m < 4; ++m)
#pragma unroll
                    for (int n = 0; n < 2; ++n) { f32x4 z_; asm volatile("v_mov_b32 %0, 0\n\tv_mov_b32 %1, 0\n\tv_mov_b32 %2, 0\n\tv_mov_b32 %3, 0" : "=v"(z_[0]), "=v"(z_[1]), "=v"(z_[2]), "=v"(z_[3])); acc[a][b][m][n] = z_; }
        cur = nxt; cA = nA; cB = nB; ++ui;
        if (wr == 1) PG8_BAR;
    }
    PG8_WAIT_V(0);
    PG8_BAR;
#undef PG8_SA
#undef PG8_SB
#undef PG8_STAGE
#undef PG8_LDA
#undef PG8_LDB
#undef PG8_MMA
#undef PG8_WAIT_V
#undef PG8_WAIT_L
#undef PG8_BAR
#undef PG8_SCHED
}

struct EpiProj {
    bf16_t* O; const float* bias; int nostore; unsigned char* G;
    __device__ __forceinline__ void operator()(const f32x4 (&acc)[2][2][4][2], const Unit& u, int wr, int wc, int fr, int fq) const {
        if (nostore) return;
        const int row0 = u.pm * BM + wr * 64 + fr, col0 = u.pn * BM + wc * 32 + 8 * fq;
        const bool sig = (u.pn * BM >= C_GA);
        const int gt = sig ? u.pn - C_GA / BM : 0;
        int lo_ = ((wr * 4 + wc) * 64 + fq * 16 + fr) * 8; asm volatile("" : "+v"(lo_));
        unsigned char* gbase = G + ((size_t)((gt >> 2) * (T / BM) + u.pm) * 4 + (gt & 3)) * (BM * BM) + (size_t)lo_;
        f32x4 bz0[2], bz1[2];
#pragma unroll
        for (int bj = 0; bj < 2; ++bj) { bz0[bj] = *(const f32x4*)(bias + col0 + bj * HALF); bz1[bj] = *(const f32x4*)(bias + col0 + bj * HALF + 4); }
#pragma unroll
        for (int ai = 0; ai < 2; ++ai)
#pragma unroll
            for (int m = 0; m < 4; ++m) { bf16_t* rowp = O + (size_t)(row0 + ai * HALF + m * 16) * PP + col0;
#pragma unroll
                for (int bj = 0; bj < 2; ++bj) { f32x4 v0 = acc[ai][bj][m][0] + bz0[bj], v1 = acc[ai][bj][m][1] + bz1[bj];
                    if (sig) {
#pragma unroll
                        for (int q = 0; q < 4; ++q) { v0[q] = fast_rcp(1.0f + fast_exp2(-LOG2E * v0[q])); v1[q] = fast_rcp(1.0f + fast_exp2(-LOG2E * v1[q])); }
                    }
                    if (sig) { u32x2 w8; w8.x = pk4_fp8(v0[0] * SG8, v0[1] * SG8, v0[2] * SG8, v0[3] * SG8); w8.y = pk4_fp8(v1[0] * SG8, v1[1] * SG8, v1[2] * SG8, v1[3] * SG8); *(u32x2*)(gbase + (size_t)(((ai * 4 + m) * 2 + bj) * 4096)) = w8; }
                    else { u32x4 w; w.x = cvt_pk_bf16(v0[0], v0[1]); w.y = cvt_pk_bf16(v0[2], v0[3]); w.z = cvt_pk_bf16(v1[0], v1[1]); w.w = cvt_pk_bf16(v1[2], v1[3]); *(u32x4*)(rowp + bj * HALF) = w; } }  asm volatile("" ::: "memory"); }
    }
};
struct EpiPlain {
    bf16_t* O; int ldc;
    __device__ __forceinline__ void operator()(const f32x4 (&acc)[2][2][4][2], const Unit& u, int wr, int wc, int fr, int fq) const {
        const int row0 = u.pm * BM + wr * 64 + fr, col0 = u.pn * BM + wc * 32 + 8 * fq;
#pragma unroll
        for (int ai = 0; ai < 2; ++ai)
#pragma unroll
            for (int m = 0; m < 4; ++m) { bf16_t* rowp = O + (size_t)(row0 + ai * HALF + m * 16) * ldc + col0;
#pragma unroll
                for (int bj = 0; bj < 2; ++bj) { const f32x4 v0 = acc[ai][bj][m][0], v1 = acc[ai][bj][m][1];
                    u32x4 w; w.x = cvt_pk_bf16(v0[0], v0[1]); w.y = cvt_pk_bf16(v0[2], v0[3]); w.z = cvt_pk_bf16(v1[0], v1[1]); w.w = cvt_pk_bf16(v1[2], v1[3]);
                    *(u32x4*)(rowp + bj * HALF) = w; }  asm volatile("" ::: "memory"); }
    }
};
struct EpiPlain8 {
    unsigned char* O; int ldc; float sc;
    __device__ __forceinline__ void operator()(const f32x4 (&acc)[2][2][4][2], const Unit& u, int wr, int wc, int fr, int fq) const {
        const int row0 = u.pm * BM + wr * 64 + fr, col0 = u.pn * BM + wc * 32 + 8 * fq;
#pragma unroll
        for (int ai = 0; ai < 2; ++ai)
#pragma unroll
            for (int m = 0; m < 4; ++m) { unsigned char* rowp = O + (size_t)(row0 + ai * HALF + m * 16) * ldc + col0;
#pragma unroll
                for (int bj = 0; bj < 2; ++bj) { const f32x4 v0 = acc[ai][bj][m][0], v1 = acc[ai][bj][m][1];
                    u32x2 w; w.x = pk4_fp8(v0[0] * sc, v0[1] * sc, v0[2] * sc, v0[3] * sc); w.y = pk4_fp8(v1[0] * sc, v1[1] * sc, v1[2] * sc, v1[3] * sc);
                    *(u32x2*)(rowp + bj * HALF) = w; } asm volatile("" ::: "memory"); }
    }
};
struct EpiMerge {
    unsigned char* O; const unsigned char* G; int nostore;
    static __device__ __forceinline__ void dec8(const u32x2 g, float (&f)[8]) {
        const f32x2 a = __builtin_amdgcn_cvt_pk_f32_fp8((int)g.x, false), b = __builtin_amdgcn_cvt_pk_f32_fp8((int)g.x, true), c = __builtin_amdgcn_cvt_pk_f32_fp8((int)g.y, false), d = __builtin_amdgcn_cvt_pk_f32_fp8((int)g.y, true);
        f[0] = a[0]; f[1] = a[1]; f[2] = b[0]; f[3] = b[1]; f[4] = c[0]; f[5] = c[1]; f[6] = d[0]; f[7] = d[1]; }
    __device__ __forceinline__ void mid(f32x4 (&acc)[2][2][4][2], const Unit& u, int wr, int wc, int fr, int fq) const {
        if (nostore) return;
        int lo = ((wr * 4 + wc) * 64 + fq * 16 + fr) * 8;
        asm volatile("" : "+v"(lo));
        const unsigned char* ga_p = G + ((size_t)u.pm * 4 + u.pn) * (BM * BM) + lo; const unsigned char* gb_p = ga_p + (size_t)(T / BM) * 4 * (BM * BM);
#pragma unroll
        for (int ai = 0; ai < 2; ++ai) {
            u32x2 gav[8], gbv[8];
#pragma unroll
            for (int i = 0; i < 8; ++i) { const int po = (ai * 8 + i) * 4096; gav[i] = *(const u32x2*)(ga_p + po); gbv[i] = *(const u32x2*)(gb_p + po); }
#pragma unroll
            for (int m = 0; m < 4; ++m)
#pragma unroll
                for (int bj = 0; bj < 2; ++bj) { float fa[8], fb[8]; dec8(gav[m * 2 + bj], fa); dec8(gbv[m * 2 + bj], fb);
#pragma unroll
                    for (int q = 0; q < 4; ++q) { acc[ai][bj][m][0][q] *= fa[q] * fast_rcp(fmaxf(fb[q], 0.001953125f)); acc[ai][bj][m][1][q] *= fa[4 + q] * fast_rcp(fmaxf(fb[4 + q], 0.001953125f)); } }
        }
    }
    __device__ __forceinline__ void operator()(const f32x4 (&acc)[2][2][4][2], const Unit& u, int wr, int wc, int fr, int fq) const {
        if (nostore) return;
        const int row0 = u.pm * BM + wr * 64 + fr, col0 = u.pn * BM + wc * 32 + 8 * fq;
        int lo_ = ((wr * 4 + wc) * 64 + fq * 16 + fr) * 8; asm volatile("" : "+v"(lo_));
        const unsigned char* gb_p = G + ((size_t)(T / BM + u.pm) * 4 + u.pn) * (BM * BM) + (size_t)lo_;
        constexpr float SO = SM8 / SG8;
        u32x2 gbv[16];
#pragma unroll
        for (int i = 0; i < 16; ++i) gbv[i] = *(const u32x2*)(gb_p + i * 4096);
#pragma unroll
        for (int ai = 0; ai < 2; ++ai)
#pragma unroll
            for (int m = 0; m < 4; ++m) { const size_t row = (size_t)(row0 + ai * HALF + m * 16);
                unsigned char* rowp = O + row * D + col0;
#pragma unroll
                for (int bj = 0; bj < 2; ++bj) { const f32x4 v0 = acc[ai][bj][m][0], v1 = acc[ai][bj][m][1];
                    float fb[8]; dec8(gbv[(ai * 4 + m) * 2 + bj], fb);
                    float o[8];
#pragma unroll
                    for (int q = 0; q < 4; ++q) { o[q] = fmaxf(fb[q], 0.001953125f) * v0[q] * SO; o[4 + q] = fmaxf(fb[4 + q], 0.001953125f) * v1[q] * SO; }
                    u32x2 w; w.x = pk4_fp8(o[0], o[1], o[2], o[3]); w.y = pk4_fp8(o[4], o[5], o[6], o[7]);
                    *(u32x2*)(rowp + bj * HALF) = w; } asm volatile("" ::: "memory"); }
    }
};
struct EpiSwiglu {
    unsigned char* O;
    __device__ __forceinline__ void operator()(const f32x4 (&acc)[2][2][4][2], const Unit& u, int wr, int wc, int fr, int fq) const {
        const int row0 = u.pm * BM + wr * 64 + fr, col0 = u.pn * HALF + wc * 32 + 8 * fq;
#pragma unroll
        for (int ai = 0; ai < 2; ++ai)
#pragma unroll
            for (int m = 0; m < 4; ++m) { unsigned char* rowp = O + (size_t)(row0 + ai * HALF + m * 16) * DE + col0;
                float o[8];
#pragma unroll
                for (int n = 0; n < 2; ++n)
#pragma unroll
                    for (int q = 0; q < 4; ++q) { const float g = acc[ai][0][m][n][q], up = acc[ai][1][m][n][q]; o[4 * n + q] = g * fast_rcp(1.0f + fast_exp2(-LOG2E * g)) * up * SH8; }
                u32x2 w; w.x = pk4_fp8(o[0], o[1], o[2], o[3]); w.y = pk4_fp8(o[4], o[5], o[6], o[7]);
                *(u32x2*)rowp = w; asm volatile("" ::: "memory"); }
    }
};

struct SchedStatic {
    const char* A; const char* Bt; int nM, nN, G, c; size_t tstep;
    __device__ __forceinline__ bool next(int i, Unit& u) const { u.aux = 0; return static_tile(nM, nN, G, c, i, u.pm, u.pn); }
    __device__ __forceinline__ const char* abase(const Unit& u) const { return A + (size_t)u.pm * tstep; }
    __device__ __forceinline__ const char* bbase(const Unit& u) const { return Bt + (size_t)u.pn * tstep; }
};
struct SchedTwoSeg {
    const char* A0; long adiff; const char* B0; long bdiff; int nM, nN, G, c; size_t tile_bytes;
    __device__ __forceinline__ bool next(int i, Unit& u) const { u.aux = 0; return static_tile(nM, nN, G, c, i, u.pm, u.pn); }
    __device__ __forceinline__ const char* abase(const Unit& u) const { return A0 + (size_t)u.pm * tile_bytes; }
    __device__ __forceinline__ const char* bbase(const Unit& u) const { return B0 + (size_t)u.pn * tile_bytes; }
};
struct SchedMoe {
    const char* A; const char* Bt; const int* tok; const LAS int* t2e; const LAS int* tstart; const LAS int* cnt; int ntiles, G, vcu; size_t a_tile_bytes, b_exp_bytes, b_tile_bytes; int row_bytes;
    __device__ __forceinline__ bool next(int i, Unit& u) const { const int L = i * G + vcu; if (L >= 4 * ntiles) return false; u.pm = L >> 2; u.pn = L & 3; u.aux = t2e[u.pm]; return true; }
    __device__ __forceinline__ const char* abase(const Unit& u) const { return A + (size_t)u.pm * a_tile_bytes; }
    __device__ __forceinline__ const char* bbase(const Unit& u) const { return Bt + (size_t)u.aux * b_exp_bytes + (size_t)u.pn * b_tile_bytes; }
    __device__ __forceinline__ void gather(const Unit& u, const int (&R)[2], const int (&C)[2], unsigned (&voff)[2][2]) const {
        const int e = u.aux, lt = u.pm - tstart[e], nvalid = cnt[e] - lt * 256; const int* list = tok + (size_t)e * TOKCAP + lt * 256;
#pragma unroll
        for (int h = 0; h < 2; ++h)
#pragma unroll
            for (int i = 0; i < 2; ++i) { int r = h * HALF + R[i]; r = r < nvalid ? r : nvalid - 1; const int t = list[r]; voff[h][i] = (unsigned)(t * row_bytes + C[i] * 2); }
    }
    __device__ __forceinline__ void gather_issue(const Unit& u, const int (&R)[2], unsigned (&raw)[2][2]) const {
        const int e = u.aux, lt = u.pm - tstart[e], nvalid = cnt[e] - lt * 256; const int* list = tok + (size_t)e * TOKCAP + lt * 256;
#pragma unroll
        for (int h = 0; h < 2; ++h)
#pragma unroll
            for (int i = 0; i < 2; ++i) { int r = h * HALF + R[i]; r = r < nvalid ? r : nvalid - 1; asm volatile("global_load_dword %0, %1, off" : "=v"(raw[h][i]) : "v"(list + r) : "memory"); }
    }
    __device__ __forceinline__ unsigned gather_finish(unsigned raw, int c) const { asm volatile("" : "+v"(raw)); return (unsigned)((int)raw * row_bytes + c * 2); }
};
}

struct Frame {
    LAS unsigned char* lds;
    gu32* ctl;
    int tid, lane, wave, vcu, G, bid;
};

__device__ __forceinline__ void p0_transpose_item(const float* W, int K, int N, bf16_t* WT, int k0, int n0, int dst_row0, float sc, LAS float* scr, int lane) {
    const int q = lane & 7, ks = lane >> 3;
    f32x4 vv[8];
#pragma unroll
    for (int it = 0; it < 8; ++it) asm volatile("global_load_dwordx4 %0, %1, off nt" : "=v"(vv[it]) : "v"(W + (size_t)(k0 + it * 8 + ks) * N + n0 + 4 * q) : "memory");
    asm volatile("s_waitcnt vmcnt(0)" : "+v"(vv[0]), "+v"(vv[1]), "+v"(vv[2]), "+v"(vv[3]), "+v"(vv[4]), "+v"(vv[5]), "+v"(vv[6]), "+v"(vv[7]) :: "memory");
#pragma unroll
    for (int it = 0; it < 8; ++it) { const int kk = it * 8 + ks; const f32x4 v = vv[it];
        scr[kk * 33 + 4 * q + 0] = v[0]; scr[kk * 33 + 4 * q + 1] = v[1]; scr[kk * 33 + 4 * q + 2] = v[2]; scr[kk * 33 + 4 * q + 3] = v[3]; }
    asm volatile("s_waitcnt lgkmcnt(0)" ::: "memory");
    const int c = lane & 7;
#pragma unroll
    for (int j = 0; j < 4; ++j) { const int n = (lane >> 3) + 8 * j; const LAS float* s = scr + (8 * c) * 33 + n;
        u32x4 o; o.x = cvt_pk_bf16(s[0 * 33] * sc, s[1 * 33] * sc); o.y = cvt_pk_bf16(s[2 * 33] * sc, s[3 * 33] * sc); o.z = cvt_pk_bf16(s[4 * 33] * sc, s[5 * 33] * sc); o.w = cvt_pk_bf16(s[6 * 33] * sc, s[7 * 33] * sc);
        __builtin_nontemporal_store(o, (u32x4*)(WT + (size_t)(dst_row0 + n) * K + k0 + 8 * c)); }
    asm volatile("s_waitcnt lgkmcnt(0)" ::: "memory");
}

__device__ __forceinline__ void p0_transpose_item_f8(const float* W, int K, int N, unsigned char* WT, int k0, int n0, int dst_row0, float sc, LAS float* scr, int lane) {
    const int q = lane & 7, ks = lane >> 3;
    f32x4 vv[8];
#pragma unroll
    for (int it = 0; it < 8; ++it) asm volatile("global_load_dwordx4 %0, %1, off nt" : "=v"(vv[it]) : "v"(W + (size_t)(k0 + it * 8 + ks) * N + n0 + 4 * q) : "memory");
    asm volatile("s_waitcnt vmcnt(0)" : "+v"(vv[0]), "+v"(vv[1]), "+v"(vv[2]), "+v"(vv[3]), "+v"(vv[4]), "+v"(vv[5]), "+v"(vv[6]), "+v"(vv[7]) :: "memory");
#pragma unroll
    for (int it = 0; it < 8; ++it) { const int kk = it * 8 + ks; const f32x4 v = vv[it];
        scr[kk * 33 + 4 * q + 0] = v[0]; scr[kk * 33 + 4 * q + 1] = v[1]; scr[kk * 33 + 4 * q + 2] = v[2]; scr[kk * 33 + 4 * q + 3] = v[3]; }
    asm volatile("s_waitcnt lgkmcnt(0)" ::: "memory");
    const int c = lane & 7;
#pragma unroll
    for (int j = 0; j < 4; ++j) { const int n = (lane >> 3) + 8 * j; const LAS float* s = scr + (8 * c) * 33 + n;
        u32x2 o; o.x = pk4_fp8(s[0 * 33] * sc, s[1 * 33] * sc, s[2 * 33] * sc, s[3 * 33] * sc); o.y = pk4_fp8(s[4 * 33] * sc, s[5 * 33] * sc, s[6 * 33] * sc, s[7 * 33] * sc);
        __builtin_nontemporal_store(o, (u32x2*)(WT + (size_t)(dst_row0 + n) * K + k0 + 8 * c)); }
    asm volatile("s_waitcnt lgkmcnt(0)" ::: "memory");
}

struct Args { const float* in[16]; float* out; unsigned char* ws; int ph_lo, ph_hi; };

constexpr int N_PHASES = 1 + 8 * DEPTH;


typedef const __attribute__((address_space(4))) Args* kargp_t;
extern __shared__ __attribute__((aligned(16))) unsigned char lds_raw[];
#define PHASE_ENTRY() Frame F; F.lds = (LAS unsigned char*)lds_raw; F.wave = wv; F.lane = lane_now(); F.tid = wv * 64 + F.lane; \
    F.G = gridDim.x; { int bx = blockIdx.x; asm volatile("" : "+s"(bx)); F.bid = bx; F.vcu = (F.G % 8 == 0) ? (bx % 8) * (F.G / 8) + bx / 8 : bx; } \
    kargp_t kp = (kargp_t)__builtin_amdgcn_kernarg_segment_ptr(); asm volatile("" : "+s"(kp)); unsigned char* ws = kp->ws; F.ctl = (gu32*)(ws + WS_CTL);
#define x_in (kp->in[0])
#define w_in (kp->in[1])
#define b_in (kp->in[2])
#define sinks (kp->in[3])
#define w_bra (kp->in[4])
#define w_brb (kp->in[5])
#define w_out (kp->in[6])
#define ln1_g (kp->in[7])
#define ln1_b (kp->in[8])
#define w_router (kp->in[9])
#define router_bias (kp->in[10])
#define w_gate (kp->in[11])
#define w_up (kp->in[12])
#define w_down (kp->in[13])
#define ln2_g (kp->in[14])
#define ln2_b (kp->in[15])
#define xres (kp->out)
#define bias_s ((float*)(ws + WS_BIAS))
#define Win_t ((bf16_t*)(ws + WS_WIN))
#define Wa_t ((bf16_t*)(ws + WS_WA))
#define Wb_t ((bf16_t*)(ws + WS_WB))
#define Wo_t ((bf16_t*)(ws + WS_WO))
#define Wgu_t ((bf16_t*)(ws + WS_WGU))
#define Wd_t ((bf16_t*)(ws + WS_WD))
#define xb ((bf16_t*)(ws + WS_XB))
#define proj ((bf16_t*)(ws + WS_PROJ))
#define hbuf ((bf16_t*)(ws + WS_H))
#define y2 ((bf16_t*)(ws + WS_Y2))
#define ya ((bf16_t*)(ws + WS_YA))
#define yb ((bf16_t*)(ws + WS_YB))
#define mix ((unsigned char*)(ws + WS_MIX))
#define merged ((bf16_t*)(ws + WS_MERGED))
#define tok ((int*)(ws + WS_TOK))
#define slot_e ((int*)(ws + WS_SLOT))
#define slot_r (slot_e + T * 2)
#define slot_g ((float*)(slot_r + T * 2))


namespace att {
typedef float f32x16 __attribute__((ext_vector_type(16)));
typedef short s16x4 __attribute__((ext_vector_type(4)));
typedef short v4i16_t __attribute__((ext_vector_type(4)));
constexpr int SLOTB = 8192, NSLOT = 6;
constexpr int LDS_K = 0, LDS_V = NSLOT * SLOTB, LDS_OST = 2 * NSLOT * SLOTB;
static_assert(LDS_OST + 8 * 4096 <= RING_BYTES, "attention LDS map");
__device__ __forceinline__ int crow(int r, int hi) { return (r & 3) + 8 * (r >> 2) + 4 * hi; }
__device__ __forceinline__ void glds16(const void* gsrc, unsigned lds_dst) { unsigned keep;
    asm volatile("s_mov_b32 %0, m0\n\ts_mov_b32 m0, %2\n\ts_nop 0\n\tglobal_load_lds_dwordx4 %1, off\n\ts_mov_b32 m0, %0" : "=&s"(keep) : "v"(gsrc), "s"(lds_dst) : "memory"); }
typedef const LAS char* lds_cptr;
__device__ __forceinline__ void kload8(bf16x8* kf, lds_cptr kp) {
    kf[0] = *(const LAS bf16x8*)(kp);        kf[1] = *(const LAS bf16x8*)(kp + 512);
    kf[2] = *(const LAS bf16x8*)(kp + 2048); kf[3] = *(const LAS bf16x8*)(kp + 2560);
    kf[4] = *(const LAS bf16x8*)(kp + 4096); kf[5] = *(const LAS bf16x8*)(kp + 4608);
    kf[6] = *(const LAS bf16x8*)(kp + 6144); kf[7] = *(const LAS bf16x8*)(kp + 6656);
}
__device__ __forceinline__ s16x4 vtr(lds_cptr p) { return __builtin_bit_cast(s16x4, __builtin_amdgcn_ds_read_tr16_b64_v4i16((LAS v4i16_t*)p)); }
__device__ __forceinline__ void qkt(f32x16& p0, f32x16& p1, const bf16x8* kf, const bf16x8* qr) {
    p0 = (f32x16){}; p1 = (f32x16){};
#pragma unroll
    for (int d0 = 0; d0 < 4; ++d0) { p0 = __builtin_amdgcn_mfma_f32_32x32x16_bf16(kf[2 * d0], qr[d0], p0, 0, 0, 0); p1 = __builtin_amdgcn_mfma_f32_32x32x16_bf16(kf[2 * d0 + 1], qr[d0], p1, 0, 0, 0); }
}
__device__ __forceinline__ void pv_ks(f32x16* o, lds_cptr vp, int ks, bf16x8 pa) {
#pragma unroll
    for (int d0 = 0; d0 < 2; ++d0) {
        const s16x4 lo = vtr(vp + d0 * 4096 + ks * 1024), hi = vtr(vp + d0 * 4096 + ks * 1024 + 512);
        const bf16x8 vf = (bf16x8){lo[0], lo[1], lo[2], lo[3], hi[0], hi[1], hi[2], hi[3]};
        o[d0] = __builtin_amdgcn_mfma_f32_32x32x16_bf16(pa, vf, o[d0], 0, 0, 0);
    }
}
__device__ __forceinline__ bf16x8 pack8(const f32x16& p, int b) {
    u32x4 w; w.x = cvt_pk_bf16(p[b], p[b + 1]); w.y = cvt_pk_bf16(p[b + 2], p[b + 3]); w.z = cvt_pk_bf16(p[b + 4], p[b + 5]); w.w = cvt_pk_bf16(p[b + 6], p[b + 7]);
    return __builtin_bit_cast(bf16x8, w);
}
__device__ __forceinline__ void store_o(const f32x16* o, LAS char* stage, unsigned char* dst, int ldo, int lane) {
    const int r32 = lane & 31, hi = lane >> 5;
    LAS unsigned char* stg = (LAS unsigned char*)stage;
#pragma unroll
    for (int r = 0; r < 16; ++r) { const int orow = crow(r, hi);
        const unsigned w = (unsigned)__builtin_amdgcn_cvt_pk_fp8_f32(o[0][r] * SY8, o[1][r] * SY8, 0, false);
        stg[orow * 64 + r32] = (unsigned char)(w & 0xffu); stg[orow * 64 + 32 + r32] = (unsigned char)((w >> 8) & 0xffu); }
    asm volatile("s_waitcnt lgkmcnt(0)" ::: "memory");
#pragma unroll
    for (int i = 0; i < 2; ++i) { const int piece = i * 64 + lane, row = piece >> 2, ch = piece & 3; const u32x4 v = *(const LAS u32x4*)(stg + row * 64 + ch * 16); *(u32x4*)(dst + (size_t)row * ldo + ch * 16) = v; }
    asm volatile("s_waitcnt lgkmcnt(0)" ::: "memory");
}
#define ATT_WAIT_BAR(N) asm volatile("s_waitcnt vmcnt(" #N ") lgkmcnt(0)\n\ts_barrier" ::: "memory")

__device__ __forceinline__ void sb_unit(int b, int hp, int qb, const bf16_t* pj, unsigned char* yout, LAS char* lds, LAS int* flags, int tid) {
    const int lane = tid & 63, r32 = lane & 31, hi = lane >> 5; const int wid = __builtin_amdgcn_readfirstlane(tid >> 6);
    const int grp = wid >> 2, lw = wid & 3, h = 2 * hp + grp;
    const size_t rowbase = (size_t)b * SEQ; const int q0 = qb * 128;
    const bf16_t* Qw = pj + (rowbase + q0 + lw * 32) * PP + C_SQ + h * 64;
    const bf16_t* Kh = pj + rowbase * PP + C_SK + h * 64; const bf16_t* Vh = pj + rowbase * PP + C_SV + h * 64;
    const unsigned lds0 = (unsigned)(uintptr_t)lds;
    const bf16_t* ksrc = Kh + (size_t)lane * PP + (2 * lw) * 8;
    const bf16_t* vsrc0 = Vh + (size_t)(16 * ((2 * lw) & 3) + (lane >> 2)) * PP + ((2 * lw) >> 2) * 32 + (lane & 3) * 8;
    const bf16_t* vsrc1 = Vh + (size_t)(16 * ((2 * lw + 1) & 3) + (lane >> 2)) * PP + ((2 * lw + 1) >> 2) * 32 + (lane & 3) * 8;
    const unsigned kdst = lds0 + LDS_K + grp * 3 * SLOTB + (2 * lw) * 1024, vdst = lds0 + LDS_V + grp * 3 * SLOTB + (2 * lw) * 1024;
#define SB_DMA(t, slot) do { const size_t to_ = (size_t)(t) * 64 * PP; \
        glds16(ksrc + to_, (unsigned)__builtin_amdgcn_readfirstlane(kdst + (slot))); glds16(ksrc + to_ + 8, (unsigned)__builtin_amdgcn_readfirstlane(kdst + (slot) + 1024)); \
        glds16(vsrc0 + to_, (unsigned)__builtin_amdgcn_readfirstlane(vdst + (slot))); glds16(vsrc1 + to_, (unsigned)__builtin_amdgcn_readfirstlane(vdst + (slot) + 1024)); } while (0)
    const lds_cptr kp0 = (lds_cptr)lds + LDS_K + grp * 3 * SLOTB + hi * 1024 + r32 * 16;
    const lds_cptr vp0 = (lds_cptr)lds + LDS_V + grp * 3 * SLOTB + ((lane >> 4) & 1) * 32 + (lane & 3) * 8 + (4 * hi + ((lane & 15) >> 2)) * 64;
    const int jhi = 2 * qb + 1, jw = 2 * qb + (lw >> 1);
    bf16x8 qr[4];
#pragma unroll
    for (int d0 = 0; d0 < 4; ++d0) qr[d0] = *(const bf16x8*)(Qw + (size_t)r32 * PP + d0 * 16 + hi * 8);
    SB_DMA(jhi, 0); SB_DMA(jhi - 1, SLOTB);
    asm volatile("s_waitcnt vmcnt(8)" : "+v"(qr[0]), "+v"(qr[1]), "+v"(qr[2]), "+v"(qr[3]) :: "memory");
    if (tid < 16) flags[tid] = 0;
    f32x16 o[2]; o[0] = (f32x16){}; o[1] = (f32x16){};
    float carry = 1.0f; bool done = false;
    const int trow = 32 * (lw & 1) + r32;
    const int lag = (lw < 2) ? 1 : 0;
    int sl_m = lag ? SLOTB : 0;
    int sl_cur = 0, sl_n2 = 2 * SLOTB;
    for (int n = 0;; ++n) {
        const int j = jhi - n; if (j < 0) break;
        ATT_WAIT_BAR(0);
        if (n > 0) { const LAS int* f = flags + ((n - 1) & 1) * 8; const int all = f[0] & f[1] & f[2] & f[3] & f[4] & f[5] & f[6] & f[7]; if (__builtin_amdgcn_readfirstlane(all)) break; }
        if (j >= 2) SB_DMA(j - 2, sl_n2);
        const int jm = j - lag;
        const bool active = (jm >= 0) && !done;
        if (active) {
            const bool diag = (jm == jw);
            const bool skip1 = diag && !(lw & 1);
            bf16x8 kf[8]; kload8(kf, kp0 + sl_m);
            f32x16 p0 = (f32x16){}, p1 = (f32x16){};
#pragma unroll
            for (int d0 = 0; d0 < 4; ++d0) p0 = __builtin_amdgcn_mfma_f32_32x32x16_bf16(kf[2 * d0], qr[d0], p0, 0, 0, 0);
            if (!skip1) {
#pragma unroll
                for (int d0 = 0; d0 < 4; ++d0) p1 = __builtin_amdgcn_mfma_f32_32x32x16_bf16(kf[2 * d0 + 1], qr[d0], p1, 0, 0, 0);
            }
            const int lim = diag ? trow : 4096;
            const lds_cptr vp = vp0 + sl_m;
#pragma unroll
            for (int blk = 1; blk >= 0; --blk) {
                if (blk == 1 && skip1) continue;
                f32x16& p = blk ? p1 : p0;
                float G[4];
#pragma unroll
                for (int g = 0; g < 4; ++g) {
#pragma unroll
                    for (int i = 0; i < 4; ++i) { const int r = 4 * g + i;
                        const float e = fast_exp2(p[r]); const float rr = fast_rcp(1.0f + e);
                        p[r] = rr; }
                    if (diag) {
#pragma unroll
                        for (int i = 0; i < 4; ++i) { const int r = 4 * g + i; p[r] = ((32 * blk + crow(r, hi)) < lim) ? p[r] : 1.0f; } }
                    G[g] = (p[4 * g] * p[4 * g + 1]) * (p[4 * g + 2] * p[4 * g + 3]);
                }
                float Tg[4], Gh[4]; float run = carry;
#pragma unroll
                for (int g = 3; g >= 0; --g) { const unsigned gu = __float_as_uint(G[g]); auto rrp = __builtin_amdgcn_permlane32_swap(gu, gu, false, false);
                    const float glo = __uint_as_float(rrp[0]), ghi = __uint_as_float(rrp[1]); Tg[g] = run; Gh[g] = ghi; run = run * (glo * ghi); }
                carry = run;
#pragma unroll
                for (int g = 0; g < 4; ++g) { float x = hi ? Tg[g] : Tg[g] * Gh[g];
                    const float k0 = p[4 * g], k1 = p[4 * g + 1], k2 = p[4 * g + 2], k3 = p[4 * g + 3];
                    float xn = x * k3; p[4 * g + 3] = x - xn; x = xn; xn = x * k2; p[4 * g + 2] = x - xn; x = xn; xn = x * k1; p[4 * g + 1] = x - xn; x = xn; p[4 * g] = x - x * k0; }
                pv_ks(o, vp, 2 * blk, pack8(p, 0)); pv_ks(o, vp, 2 * blk + 1, pack8(p, 8));
            }
            done = __all(carry < 1e-37f) || (jm == 0);
        }
        if (lane == 0) flags[(n & 1) * 8 + wid] = (done || (jm <= 0)) ? 1 : 0;
        { const int t_ = sl_cur; sl_cur = (sl_cur == 2 * SLOTB) ? 0 : sl_cur + SLOTB; sl_n2 = t_; sl_m = (sl_m == 2 * SLOTB) ? 0 : sl_m + SLOTB; }
    }
    asm volatile("s_waitcnt vmcnt(0)" ::: "memory");
    store_o(o, lds + LDS_OST + wid * 4096, yout + (rowbase + q0 + lw * 32) * 512 + h * 64, 512, lane);
    asm volatile("s_waitcnt lgkmcnt(0)\n\ts_barrier" ::: "memory");
#undef SB_DMA
}

__device__ __forceinline__ void swa_dma(const bf16_t* pj, int u, unsigned lds0, int set, int lane, int wid) {
    const int a = u & 31, kvh = (u >> 5) & 1, b = u >> 6;
    const bf16_t* Kh = pj + (size_t)b * SEQ * PP + C_AK + kvh * 64; const bf16_t* Vh = pj + (size_t)b * SEQ * PP + C_AV + kvh * 64;
#pragma unroll
    for (int i = 0; i < 3; ++i) { int jt = a - 2 + i; jt = jt < 0 ? 0 : jt;
        glds16(Kh + ((size_t)jt * 64 + lane) * PP + wid * 8, (unsigned)__builtin_amdgcn_readfirstlane(lds0 + LDS_K + (set * 3 + i) * SLOTB + wid * 1024));
        glds16(Vh + ((size_t)jt * 64 + 16 * (wid & 3) + (lane >> 2)) * PP + (wid >> 2) * 32 + (lane & 3) * 8, (unsigned)__builtin_amdgcn_readfirstlane(lds0 + LDS_V + (set * 3 + i) * SLOTB + wid * 1024)); }
}
__device__ __forceinline__ void swa_q(bf16x8* qr, const bf16_t* pj, int u, int lane, int wid) {
    const int a = u & 31, kvh = (u >> 5) & 1, b = u >> 6, g = wid >> 1, half = wid & 1, qh = kvh * 4 + g, r32 = lane & 31, hi = lane >> 5;
    const size_t row0 = (size_t)b * SEQ + a * 64 + half * 32;
#pragma unroll
    for (int d0 = 0; d0 < 4; ++d0) qr[d0] = *(const bf16x8*)(pj + (row0 + r32) * PP + C_AQ + qh * 64 + d0 * 16 + hi * 8);
}
__device__ __forceinline__ void swa_unit(int u, int set, const bf16x8* qr, unsigned char* yout, const float* sinks_l, LAS char* lds, int tid) {
    const int lane = tid & 63, r32 = lane & 31, hi = lane >> 5; const int wid = __builtin_amdgcn_readfirstlane(tid >> 6);
    const int a = u & 31, kvh = (u >> 5) & 1, b = u >> 6, g = wid >> 1, half = wid & 1, qh = kvh * 4 + g;
    const size_t row0 = (size_t)b * SEQ + a * 64 + half * 32;
    unsigned sk_; { const float* sp_ = sinks_l + qh; asm volatile("s_load_dword %0, %1, 0x0\n\ts_waitcnt lgkmcnt(0)" : "=s"(sk_) : "s"(sp_) : "memory"); }
    const float slope2 = LOG2E * exp2f(-(float)(qh + 1)), sink2 = __uint_as_float(sk_) * LOG2E;
    const lds_cptr kp0 = (lds_cptr)lds + LDS_K + set * 3 * SLOTB + hi * 1024 + r32 * 16;
    const lds_cptr vp0 = (lds_cptr)lds + LDS_V + set * 3 * SLOTB + ((lane >> 4) & 1) * 32 + (lane & 3) * 8 + (4 * hi + ((lane & 15) >> 2)) * 64;
    f32x16 s[3][2];
#pragma unroll
    for (int i = 0; i < 3; ++i) { bf16x8 kf[8]; kload8(kf, kp0 + i * SLOTB);
        s[i][0] = (f32x16){}; s[i][1] = (f32x16){};
        if (!(i == 0 && half == 1)) {
#pragma unroll
            for (int d0 = 0; d0 < 4; ++d0) s[i][0] = __builtin_amdgcn_mfma_f32_32x32x16_bf16(kf[2 * d0], qr[d0], s[i][0], 0, 0, 0); }
        if (!(i == 2 && half == 0)) {
#pragma unroll
            for (int d0 = 0; d0 < 4; ++d0) s[i][1] = __builtin_amdgcn_mfma_f32_32x32x16_bf16(kf[2 * d0 + 1], qr[d0], s[i][1], 0, 0, 0); } }
    float m = sink2;
#pragma unroll
    for (int i = 0; i < 3; ++i) { const bool tile_ok = (a - 2 + i) >= 0;
#pragma unroll
        for (int blk = 0; blk < 2; ++blk) { const int dbase = 64 * (2 - i) + 32 * half + r32 - 32 * blk;
#pragma unroll
            for (int r = 0; r < 16; ++r) { const int dist = dbase - crow(r, hi); const bool valid = tile_ok && dist >= 0 && dist < 128;
                const float v = s[i][blk][r] - slope2 * (float)dist; s[i][blk][r] = valid ? v : -INFINITY; m = fmaxf(m, s[i][blk][r]); } } }
    { const unsigned mu = __float_as_uint(m); auto rr = __builtin_amdgcn_permlane32_swap(mu, mu, false, false); m = fmaxf(__uint_as_float(rr[0]), __uint_as_float(rr[1])); }
    float lsum = 0.f;
#pragma unroll
    for (int i = 0; i < 3; ++i)
#pragma unroll
        for (int blk = 0; blk < 2; ++blk)
#pragma unroll
            for (int r = 0; r < 16; ++r) { const float pe = fast_exp2(s[i][blk][r] - m); s[i][blk][r] = pe; lsum += pe; }
    { const unsigned lu = __float_as_uint(lsum); auto rr = __builtin_amdgcn_permlane32_swap(lu, lu, false, false); lsum = __uint_as_float(rr[0]) + __uint_as_float(rr[1]); }
    const float inv = 1.0f / (lsum + fast_exp2(sink2 - m));
    f32x16 o[2]; o[0] = (f32x16){}; o[1] = (f32x16){};
#pragma unroll
    for (int i = 0; i < 3; ++i)
#pragma unroll
        for (int blk = 0; blk < 2; ++blk) {
            if ((i == 0 && blk == 0 && half == 1) || (i == 2 && blk == 1 && half == 0)) continue;
#pragma unroll
            for (int r = 0; r < 16; ++r) s[i][blk][r] *= inv;
            pv_ks(o, vp0 + i * SLOTB, 2 * blk, pack8(s[i][blk], 0)); pv_ks(o, vp0 + i * SLOTB, 2 * blk + 1, pack8(s[i][blk], 8)); }
    store_o(o, lds + LDS_OST + wid * 4096, yout + row0 * 512 + qh * 64, 512, lane);
}
}

__device__ __forceinline__ void phase_attn_mfma(int l, const int wv) {
    PHASE_ENTRY();
    LAS char* lds = (LAS char*)F.lds; LAS int* flags = (LAS int*)(F.lds + LC_HIST);
    const bool xmap = (F.G == 256); const int u_first = xmap ? (F.vcu >> 5) * 128 + (F.vcu & 31) : F.bid, u_step = xmap ? 32 : F.G;
    const int sb_end = xmap ? (F.vcu >> 5) * 128 + 128 : BATCH * 4 * 16, swa_end = xmap ? (F.vcu >> 5) * 128 + 128 : BATCH * 2 * 32;
    for (int rep_ = 0; rep_ < NREP(9); ++rep_)
    for (int u = u_first; u < sb_end; u += u_step) { const int qb = ((u & 15) + (xmap ? ((u >> 5) & 3) : (u >> 8)) * 5) & 15;
        att::sb_unit(u >> 6, (u >> 4) & 3, qb, proj, (unsigned char*)(ws + WS_YA + 16 * MiB), lds, flags, F.tid); }
    for (int rep_ = 0; rep_ < NREP(10); ++rep_) {
    const unsigned lds0 = (unsigned)(uintptr_t)lds; int set = 0;
    bf16x8 qc[4], qn[4];
#pragma unroll
    for (int d0 = 0; d0 < 4; ++d0) { qc[d0] = (bf16x8){}; qn[d0] = (bf16x8){}; }
    if (u_first < swa_end) { att::swa_q(qc, proj, u_first, F.lane, F.wave); att::swa_dma(proj, u_first, lds0, 0, F.lane, F.wave); }
    for (int u = u_first; u < swa_end; u += u_step) {
        ATT_WAIT_BAR(0);
        const bool more = (u + u_step < swa_end);
        if (more) { att::swa_q(qn, proj, u + u_step, F.lane, F.wave); att::swa_dma(proj, u + u_step, lds0, set ^ 1, F.lane, F.wave); }
        att::swa_unit(u, set, qc, (unsigned char*)(ws + WS_YA), sinks + l * 8, lds, F.tid);
        if (more) {
#pragma unroll
            for (int d0 = 0; d0 < 4; ++d0) qc[d0] = qn[d0]; }
        set ^= 1;
    }
    asm volatile("s_waitcnt vmcnt(0) lgkmcnt(0)\n\ts_barrier" ::: "memory");
    }
}


__device__ __forceinline__ int moe_tables(Frame& F, int l) {
    LAS int* cnt = (LAS int*)(F.lds + LC_CNT); LAS int* tstart = (LAS int*)(F.lds + LC_TSTART); LAS int* t2e = (LAS int*)(F.lds + LC_T2E);
    __syncthreads();
    if (F.tid < NE) cnt[F.tid] = (int)__hip_atomic_load(F.ctl + CW_CNT + 64 * l + F.tid, __ATOMIC_RELAXED, __HIP_MEMORY_SCOPE_AGENT);
    __syncthreads();
    if (F.tid == 0) { int s = 0; for (int e = 0; e < NE; ++e) { tstart[e] = s; s += (cnt[e] + 255) >> 8; } tstart[NE] = s; }
    __syncthreads();
    if (F.tid < NE) { const int s = tstart[F.tid], n = (cnt[F.tid] + 255) >> 8; for (int j = 0; j < n; ++j) t2e[s + j] = F.tid; }
    __syncthreads();
    return tstart[NE];
}
__device__ __forceinline__ int moe_tables_cached(Frame& F, int l) {
#if MK_ONE_LAUNCH
    (void)l; return ((const LAS int*)(F.lds + LC_TSTART))[NE];
#else
    return moe_tables(F, l);
#endif
}


constexpr int CI_IN = (D / 64) * (NIN / 32), CI_BR = (512 / 64) * (D / 32), CI_WO = (D / 64) * (D / 32), CI_GU = NE * (D / 64) * (DE / 32), CI_DN = NE * (DE / 64) * (D / 32);
constexpr int NPL = CI_IN + 2 * CI_BR + CI_WO + 2 * CI_GU + CI_DN;
__device__ __forceinline__ void convert_item(kargp_t kp, unsigned char* ws, int l, int r, LAS float* scr, int lane) {
    const float* W; unsigned char* WT; int K, N, k0, n0, drow; float sc = 1.0f; bool f8 = true;
    if (r < CI_IN) { const int kb = r / (NIN / 32), nb = r % (NIN / 32); n0 = nb * 32; k0 = kb * 64; drow = n0; K = D; N = NIN;
        sc = (((n0 < C_AK) || (n0 >= C_SQ && n0 < C_SK)) ? C2 : 1.0f) * SW8; W = w_in + (size_t)l * D * NIN; WT = (unsigned char*)(ws + WS_WIN) + (size_t)l * NIN * D; }
    else if ((r -= CI_IN) < 2 * CI_BR) { const int bb = r >= CI_BR; if (bb) r -= CI_BR; const int kb = r / (D / 32), nb = r % (D / 32); n0 = nb * 32; k0 = kb * 64; drow = n0; K = 512; N = D; sc = SW8;
        W = (bb ? w_brb : w_bra) + (size_t)l * 512 * D; WT = (unsigned char*)(ws + (bb ? WS_WB : WS_WA)) + (size_t)l * D * 512; }
    else if ((r -= 2 * CI_BR) < CI_WO) { const int kb = r / (D / 32), nb = r % (D / 32); n0 = nb * 32; k0 = kb * 64; drow = n0; K = D; N = D; sc = SW8;
        W = w_out + (size_t)l * D * D; WT = (unsigned char*)(ws + WS_WO) + (size_t)l * D * D; }
    else if ((r -= CI_WO) < 2 * CI_GU) { sc = SW8; const int up = r >= CI_GU; if (up) r -= CI_GU; constexpr int per = (D / 64) * (DE / 32); const int le = l * NE + r / per, q = r % per, kb = q / (DE / 32), nb = q % (DE / 32);
        n0 = nb * 32; k0 = kb * 64; drow = (n0 >> 7) * 256 + (n0 & 127) + (up ? 128 : 0); K = D; N = DE;
        W = (up ? w_up : w_gate) + (size_t)le * D * DE; WT = (unsigned char*)(ws + WS_WGU) + (size_t)le * 1024 * D; }
    else { r -= 2 * CI_GU; constexpr int per = (DE / 64) * (D / 32); const int le = l * NE + r / per, q = r % per, kb = q / (D / 32), nb = q % (D / 32); n0 = nb * 32; k0 = kb * 64; drow = n0; K = DE; N = D; sc = SW8;
        W = w_down + (size_t)le * DE * D; WT = (unsigned char*)(ws + WS_WD) + (size_t)le * D * DE; }
    if (f8) p0_transpose_item_f8(W, K, N, WT, k0, n0, drow, sc, scr, lane);
    else p0_transpose_item(W, K, N, (bf16_t*)WT, k0, n0, drow, sc, scr, lane);
}
constexpr int CW_CQ = 12288;
constexpr int QB = 32, QTOTAL = (DEPTH - 1) * NPL;
static_assert(QTOTAL % QB == 0, "queue batches");
constexpr int LW_REL = 12, LW_Q = 13, LW_GEN = 14, LW_QDONE = 15;
__device__ __forceinline__ int cq_take(unsigned char* ws, int lane, int claim_limit) {
    volatile LAS int* misc = (volatile LAS int*)((LAS unsigned char*)lds_raw + LC_MISC);
    gu32* cq = (gu32*)(ws + WS_CTL) + CW_CQ;
    for (int tries = 0; tries < (1 << 20); ++tries) {
        if (misc[LW_QDONE]) return -1;
        int old = 0;
        if (lane == 0) old = __hip_atomic_fetch_add((LAS int*)((LAS unsigned char*)lds_raw + LC_MISC) + LW_Q, 1, __ATOMIC_RELAXED, __HIP_MEMORY_SCOPE_WORKGROUP);
        old = __builtin_amdgcn_readfirstlane(old);
        const int i = old & 255, batch = (int)((unsigned)old >> 8);
        if (i < QB) return batch * QB + i;
        if (i == QB) {
            int nb = -1;
            if (lane == 0) { const int p = (int)__hip_atomic_load(cq, __ATOMIC_RELAXED, __HIP_MEMORY_SCOPE_AGENT); if (p * QB < claim_limit) nb = (int)__hip_atomic_fetch_add(cq, 1u, __ATOMIC_RELAXED, __HIP_MEMORY_SCOPE_AGENT); }
            nb = __builtin_amdgcn_readfirstlane(nb);
            if (nb < 0) { if (lane == 0) misc[LW_Q] = (batch << 8) | QB; return -1; }
            if (nb * QB >= QTOTAL) { if (lane == 0) { misc[LW_QDONE] = 1; misc[LW_Q] = (batch << 8) | QB; } return -1; }
            if (lane == 0) misc[LW_Q] = (nb << 8) | 1;
            return nb * QB;
        }
        while ((misc[LW_Q] & 255) > QB && !misc[LW_QDONE]) __builtin_amdgcn_s_sleep(2);
    }
    return -1;
}
__device__ __forceinline__ bool cq_step(kargp_t kp, unsigned char* ws, LAS float* scr, int lane, int claim_limit) {
    const int k = cq_take(ws, lane, claim_limit);
    if (k < 0) return false;
    convert_item(kp, ws, 1 + k / NPL, k % NPL, scr, lane);
    return true;
}

__device__ __forceinline__ void phase_prologue(const int wv) {
    PHASE_ENTRY();
    LAS float* scr = (LAS float*)(F.lds + F.wave * 16384);
    const int gw = F.vcu * NWAVES + F.wave, NGW = F.G * NWAVES;
#if MK_ONE_LAUNCH
    constexpr int NL0 = 1;
#else
    constexpr int NL0 = DEPTH;
#endif
    for (int it = gw; it < NL0 * NPL; it += NGW) convert_item(kp, ws, it / NPL, it % NPL, scr, F.lane);
    { const size_t NV = (size_t)T * D / 4, st = (size_t)F.G * NTHREADS;
      for (size_t i0 = (size_t)F.bid * NTHREADS + F.tid; i0 < NV; i0 += 8 * st) {
        f32x4 v[8];
#pragma unroll
        for (int k = 0; k < 8; ++k) { const size_t i = i0 + k * st; v[k] = (i < NV) ? __builtin_nontemporal_load((const f32x4*)x_in + i) : (f32x4){}; }
#pragma unroll
        for (int k = 0; k < 8; ++k) { const size_t i = i0 + k * st; if (i < NV) { u32x2 o; o.x = cvt_pk_bf16(v[k][0], v[k][1]); o.y = cvt_pk_bf16(v[k][2], v[k][3]); ((u32x2*)xb)[i] = o;
            ((unsigned*)(ws + WS_XF8))[i] = pk4_fp8(v[k][0] * SX8, v[k][1] * SX8, v[k][2] * SX8, v[k][3] * SX8); } }
      } }
    for (int i = F.bid * NTHREADS + F.tid; i < DEPTH * NIN; i += F.G * NTHREADS) { const int n = i % NIN; bias_s[i] = b_in[i] * (((n < C_AK) || (n >= C_SQ && n < C_SK)) ? C2 : 1.0f); }
}

__device__ __forceinline__ void phase_ln1(int l, const bool dummy, const int wv) {
    PHASE_ENTRY();
    bf16_t* xdst = dummy ? merged : xb;
    LAS unsigned char* Tb = F.lds;
    LAS float* red = (LAS float*)F.lds;
    LAS float* Lg = (LAS float*)(F.lds + LC_LOGIT);
    LAS int* hist = (LAS int*)(F.lds + LC_HIST); LAS int* basev = (LAS int*)(F.lds + LC_BASE);
    LAS int* se = (LAS int*)(F.lds + LC_SE); LAS int* sr = (LAS int*)(F.lds + LC_SR); LAS float* sg = (LAS float*)(F.lds + LC_SG);
    const int hh = F.lane >> 5, jx = F.lane & 31;
    { LAS float* gb = (LAS float*)(F.lds + LC_GB);
      *(LAS f32x2*)(gb + 2 * F.tid) = *(const f32x2*)(ln1_g + l * D + 2 * F.tid); *(LAS f32x2*)(gb + D + 2 * F.tid) = *(const f32x2*)(ln1_b + l * D + 2 * F.tid);
      if (F.tid < NE) ((LAS float*)(F.lds + LC_RB))[F.tid] = router_bias[F.tid]; }
    bf16x8 bwh[8], bwl[8];
    float wraw[64];
#pragma unroll
    for (int s = 0; s < 64; ++s) wraw[s] = w_router[(size_t)(128 * F.wave + 16 * (s >> 3) + 8 * hh + (s & 7)) * NE + jx];
#pragma unroll
    for (int s = 0; s < 8; ++s)
#pragma unroll
        for (int i = 0; i < 8; i += 2) { const float w0 = wraw[8 * s + i], w1 = wraw[8 * s + i + 1];
            const unsigned h = cvt_pk_bf16(w0, w1); const unsigned lo = cvt_pk_bf16(w0 - bf_lo(h), w1 - bf_hi(h));
            bwh[s][i] = (short)(h & 0xffffu); bwh[s][i + 1] = (short)(h >> 16); bwl[s][i] = (short)(lo & 0xffffu); bwl[s][i + 1] = (short)(lo >> 16); }
    for (int rb = (F.G == 256) ? F.vcu : F.bid; rb < T / 128; rb += F.G) {
        if (F.tid < NE) hist[F.tid] = 0;
        __syncthreads();
        u32x2 xr[4][4]; unsigned mr[4][4];
#define LN1_LOAD_ROUND(rnd) do { _Pragma("unroll") for (int q_ = 0; q_ < 4; ++q_) { const size_t row_ = (size_t)rb * 128 + (rnd) * 32 + 4 * F.wave + q_; \
            _Pragma("unroll") for (int j_ = 0; j_ < 4; ++j_) { xr[q_][j_] = *(const u32x2*)(xb + row_ * D + 256 * j_ + 4 * F.lane); mr[q_][j_] = *(const unsigned*)((const unsigned char*)mix + row_ * D + 256 * j_ + 4 * F.lane); } } } while (0)
        LN1_LOAD_ROUND(0);
        for (int round = 0; round < 4; ++round) {
#pragma unroll
            for (int qp = 0; qp < 4; qp += 2) {
                f32x4 v[2][4]; float s[2], s2[2];
#pragma unroll
                for (int q = 0; q < 2; ++q) { s[q] = 0.f;
#pragma unroll
                    for (int j = 0; j < 4; ++j) { const u32x2 xv = xr[qp + q][j]; const f32x2 m01 = __builtin_amdgcn_cvt_pk_f32_fp8((int)mr[qp + q][j], false), m23 = __builtin_amdgcn_cvt_pk_f32_fp8((int)mr[qp + q][j], true);
                        v[q][j][0] = ALPHA * bf_lo(xv.x) + m01[0] * (1.0f / SMX8); v[q][j][1] = ALPHA * bf_hi(xv.x) + m01[1] * (1.0f / SMX8); v[q][j][2] = ALPHA * bf_lo(xv.y) + m23[0] * (1.0f / SMX8); v[q][j][3] = ALPHA * bf_hi(xv.y) + m23[1] * (1.0f / SMX8);
                        s[q] += (v[q][j][0] + v[q][j][1]) + (v[q][j][2] + v[q][j][3]); } }
                s[0] = wave_sum(s[0]); s[1] = wave_sum(s[1]);
#pragma unroll
                for (int q = 0; q < 2; ++q) { const float mean = s[q] * (1.f / D); s2[q] = 0.f;
#pragma unroll
                    for (int j = 0; j < 4; ++j) { v[q][j] = v[q][j] - mean; s2[q] += (v[q][j][0] * v[q][j][0] + v[q][j][1] * v[q][j][1]) + (v[q][j][2] * v[q][j][2] + v[q][j][3] * v[q][j][3]); } }
                s2[0] = wave_sum(s2[0]); s2[1] = wave_sum(s2[1]);
#pragma unroll
                for (int q = 0; q < 2; ++q) {
                    const int r32 = 4 * F.wave + qp + q; const size_t row = (size_t)rb * 128 + round * 32 + r32;
                    const float rstd = 1.f / sqrtf(s2[q] * (1.f / D) + LN_EPS);
#pragma unroll
                    for (int j = 0; j < 4; ++j) { const f32x4 gam = *(const LAS f32x4*)(F.lds + LC_GB + (256 * j + 4 * F.lane) * 4), bet = *(const LAS f32x4*)(F.lds + LC_GB + (D + 256 * j + 4 * F.lane) * 4); const f32x4 y = v[q][j] * rstd * gam + bet;
                        u32x2 o; o.x = cvt_pk_bf16(y[0], y[1]); o.y = cvt_pk_bf16(y[2], y[3]); *(u32x2*)(xdst + row * D + 256 * j + 4 * F.lane) = o;
                        if (!dummy) *(unsigned*)(ws + WS_XF8 + row * D + 256 * j + 4 * F.lane) = pk4_fp8(y[0] * SX8, y[1] * SX8, y[2] * SX8, y[3] * SX8);
                        *(LAS u32x2*)(Tb + r32 * 2064 + (256 * j + 4 * F.lane) * 2) = o; }
                }
            }
            if (round < 3) LN1_LOAD_ROUND(round + 1);
            __syncthreads();
            att::f32x16 acc = (att::f32x16){};
            { const LAS unsigned char* ap = Tb + jx * 2064 + (128 * F.wave + 8 * hh) * 2;
#pragma unroll
              for (int s = 0; s < 8; ++s) { const bf16x8 av = *(const LAS bf16x8*)(ap + 32 * s);
                  acc = __builtin_amdgcn_mfma_f32_32x32x16_bf16(av, bwh[s], acc, 0, 0, 0); acc = __builtin_amdgcn_mfma_f32_32x32x16_bf16(av, bwl[s], acc, 0, 0, 0); } }
            __syncthreads();
#pragma unroll
            for (int r = 0; r < 16; ++r) red[(F.wave * 32 + att::crow(r, hh)) * 32 + jx] = acc[r];
            __syncthreads();
#pragma unroll
            for (int p = 0; p < 2; ++p) { const int idx = F.tid + 512 * p, tk = idx >> 5, e = idx & 31; float s = 0.f;
#pragma unroll
                for (int w = 0; w < 8; ++w) s += red[(w * 32 + tk) * 32 + e];
                Lg[(round * 32 + tk) * 33 + e] = s; }
            __syncthreads();
        }
        __syncthreads();
        if (F.tid < 128) {
                const LAS float* lgp = Lg + F.tid * 33;
                float best = -3.0e38f; int gsel = 0; float b4[4], a4[4];
#pragma unroll
                for (int i = 0; i < 4; ++i) { b4[i] = 0.f; a4[i] = 0.f; }
#pragma unroll
                for (int g = 0; g < 8; ++g) { float af[4], bi[4];
#pragma unroll
                    for (int i = 0; i < 4; ++i) { const float lg = lgp[4 * g + i]; af[i] = 1.0f / (1.0f + __expf(-lg)); bi[i] = af[i] + ((const LAS float*)(F.lds + LC_RB))[4 * g + i]; }
                    const float h1 = fmaxf(bi[0], bi[1]), l1 = fminf(bi[0], bi[1]), h2 = fmaxf(bi[2], bi[3]), l2 = fminf(bi[2], bi[3]);
                    const float gs = fmaxf(h1, h2) + fmaxf(fminf(h1, h2), fmaxf(l1, l2));
                    const bool better = gs > best; best = better ? gs : best; gsel = better ? g : gsel;
#pragma unroll
                    for (int i = 0; i < 4; ++i) { b4[i] = better ? bi[i] : b4[i]; a4[i] = better ? af[i] : a4[i]; } }
                int i1 = 0; float m1 = b4[0];
#pragma unroll
                for (int i = 1; i < 4; ++i) { const bool gt = b4[i] > m1; m1 = gt ? b4[i] : m1; i1 = gt ? i : i1; }
                int i2 = -1; float m2 = -3.0e38f;
#pragma unroll
                for (int i = 0; i < 4; ++i) { const bool gt = (i != i1) && (b4[i] > m2); m2 = gt ? b4[i] : m2; i2 = gt ? i : i2; }
                float w1 = a4[0], w2 = a4[0];
#pragma unroll
                for (int i = 1; i < 4; ++i) { w1 = (i1 == i) ? a4[i] : w1; w2 = (i2 == i) ? a4[i] : w2; }
                const float wsum = w1 + w2;
                const int e1 = gsel * 4 + i1, e2 = gsel * 4 + i2, rloc = F.tid;
                if (dummy) { asm volatile("" :: "v"(e1), "v"(e2), "v"(wsum)); } else {
                const int r1 = __hip_atomic_fetch_add(hist + e1, 1, __ATOMIC_RELAXED, __HIP_MEMORY_SCOPE_WORKGROUP);
                const int r2 = __hip_atomic_fetch_add(hist + e2, 1, __ATOMIC_RELAXED, __HIP_MEMORY_SCOPE_WORKGROUP);
                se[2 * rloc] = e1; se[2 * rloc + 1] = e2; sr[2 * rloc] = r1; sr[2 * rloc + 1] = r2; sg[2 * rloc] = w1 / wsum; sg[2 * rloc + 1] = w2 / wsum; }
            }
        __syncthreads();
        if (F.tid < NE && !dummy) basev[F.tid] = (int)__hip_atomic_fetch_add(F.ctl + CW_CNT + 64 * l + F.tid, (unsigned)hist[F.tid], __ATOMIC_RELAXED, __HIP_MEMORY_SCOPE_AGENT);
        __syncthreads();
        if (F.tid < 256 && !dummy) { const int e = se[F.tid], rk = basev[e] + sr[F.tid]; const int t = rb * 128 + (F.tid >> 1);
            tok[(size_t)e * TOKCAP + rk] = t; slot_e[(size_t)t * 2 + (F.tid & 1)] = e; slot_r[(size_t)t * 2 + (F.tid & 1)] = rk; slot_g[(size_t)t * 2 + (F.tid & 1)] = sg[F.tid]; }
        __syncthreads();
    }
}

__device__ __forceinline__ void phase_ln2(int l, const bool dummy, const int wv) {
    PHASE_ENTRY();
    bf16_t* xdst = dummy ? merged : xb; float* fdst = dummy ? (float*)(ws + WS_YA) : xres;

            (void)moe_tables_cached(F, l);
            const LAS int* tstart = (const LAS int*)(F.lds + LC_TSTART);
            f32x4 gam[4], bet[4];
#pragma unroll
            for (int j = 0; j < 4; ++j) { gam[j] = *(const f32x4*)(ln2_g + l * D + 256 * j + 4 * F.lane); bet[j] = *(const f32x4*)(ln2_b + l * D + 256 * j + 4 * F.lane); }
            const int gw = F.bid * NWAVES + F.wave, NGW = F.G * NWAVES;
            const bool xmap = (F.G == 256); const int r_first = xmap ? 128 * F.vcu + F.wave : gw, r_pair = xmap ? 8 : NGW, r_end = xmap ? 128 * F.vcu + 128 : T;
            for (int itb = 0; r_first + 2 * r_pair * itb < r_end; itb += 16) {
            int pv; float gv;
            { const int myrow = r_first + 2 * r_pair * (itb + (F.lane >> 2)) + ((F.lane >> 1) & 1) * r_pair; const int rr = myrow < r_end ? myrow : r_first;
              const int e = slot_e[(size_t)rr * 2 + (F.lane & 1)], r = slot_r[(size_t)rr * 2 + (F.lane & 1)]; gv = slot_g[(size_t)rr * 2 + (F.lane & 1)] * (1.0f / SY28);
              pv = tstart[e] * 256 + r; }
            u32x2 xw[2][4], xn[2][4]; unsigned ya_[2][4], yb_[2][4], yan[2][4], ybn[2][4];
#define LN2_LOAD(jj_, XW, YA, YB) do { const int row0_ = r_first + 2 * r_pair * (itb + (jj_)); _Pragma("unroll") for (int q = 0; q < 2; ++q) { const int row_ = row0_ + q * r_pair; const int rr_ = row_ < r_end ? row_ : row0_; \
                    const size_t p0 = (size_t)__builtin_amdgcn_readlane(pv, 4 * (jj_) + 2 * q), p1 = (size_t)__builtin_amdgcn_readlane(pv, 4 * (jj_) + 2 * q + 1); \
                    _Pragma("unroll") for (int j = 0; j < 4; ++j) { XW[q][j] = *(const u32x2*)(xb + (size_t)rr_ * D + 256 * j + 4 * F.lane); \
                        YA[q][j] = *(const unsigned*)(ws + WS_Y2 + p0 * D + 256 * j + 4 * F.lane); YB[q][j] = *(const unsigned*)(ws + WS_Y2 + p1 * D + 256 * j + 4 * F.lane); } } } while (0)
            LN2_LOAD(0, xw, ya_, yb_);
            for (int jj = 0; jj < 16; ++jj) { const int row0 = r_first + 2 * r_pair * (itb + jj); if (row0 >= r_end) break;
                const bool more = (jj + 1 < 16) && (row0 + 2 * r_pair < r_end);
                if (more) LN2_LOAD(jj + 1, xn, yan, ybn);
                float g0[2], g1[2]; bool ok[2];
#pragma unroll
                for (int q = 0; q < 2; ++q) { const int row = row0 + q * r_pair; ok[q] = row < r_end;
                    g0[q] = __uint_as_float(__builtin_amdgcn_readlane(__float_as_uint(gv), 4 * jj + 2 * q)); g1[q] = __uint_as_float(__builtin_amdgcn_readlane(__float_as_uint(gv), 4 * jj + 2 * q + 1)); }
                f32x4 v[2][4]; float s[2], s2[2];
#pragma unroll
                for (int q = 0; q < 2; ++q) { s[q] = 0.f;
#pragma unroll
                    for (int j = 0; j < 4; ++j) { const u32x2 x_ = xw[q][j];
                        const f32x2 a01 = __builtin_amdgcn_cvt_pk_f32_fp8((int)ya_[q][j], false), a23 = __builtin_amdgcn_cvt_pk_f32_fp8((int)ya_[q][j], true), b01 = __builtin_amdgcn_cvt_pk_f32_fp8((int)yb_[q][j], false), b23 = __builtin_amdgcn_cvt_pk_f32_fp8((int)yb_[q][j], true);
                        v[q][j][0] = ALPHA * bf_lo(x_.x) + (g0[q] * a01[0] + g1[q] * b01[0]); v[q][j][1] = ALPHA * bf_hi(x_.x) + (g0[q] * a01[1] + g1[q] * b01[1]);
                        v[q][j][2] = ALPHA * bf_lo(x_.y) + (g0[q] * a23[0] + g1[q] * b23[0]); v[q][j][3] = ALPHA * bf_hi(x_.y) + (g0[q] * a23[1] + g1[q] * b23[1]);
                        s[q] += (v[q][j][0] + v[q][j][1]) + (v[q][j][2] + v[q][j][3]); } }
                s[0] = wave_sum(s[0]); s[1] = wave_sum(s[1]);
#pragma unroll
                for (int q = 0; q < 2; ++q) { const float mean = s[q] * (1.f / D); s2[q] = 0.f;
#pragma unroll
                    for (int j = 0; j < 4; ++j) { v[q][j] = v[q][j] - mean; s2[q] += (v[q][j][0] * v[q][j][0] + v[q][j][1] * v[q][j][1]) + (v[q][j][2] * v[q][j][2] + v[q][j][3] * v[q][j][3]); } }
                s2[0] = wave_sum(s2[0]); s2[1] = wave_sum(s2[1]);
#pragma unroll
                for (int q = 0; q < 2; ++q) { if (!ok[q]) continue; const int row = row0 + q * r_pair;
                    const float rstd = 1.f / sqrtf(s2[q] * (1.f / D) + LN_EPS);
#pragma unroll
                    for (int j = 0; j < 4; ++j) { const f32x4 y = v[q][j] * rstd * gam[j] + bet[j];
                        if (l == DEPTH - 1) *(f32x4*)(fdst + (size_t)row * D + 256 * j + 4 * F.lane) = y;
                        else { u32x2 o; o.x = cvt_pk_bf16(y[0], y[1]); o.y = cvt_pk_bf16(y[2], y[3]); *(u32x2*)(xdst + (size_t)row * D + 256 * j + 4 * F.lane) = o;
                            if (!dummy) *(unsigned*)(ws + WS_XF8 + (size_t)row * D + 256 * j + 4 * F.lane) = pk4_fp8(y[0] * SX8, y[1] * SX8, y[2] * SX8, y[3] * SX8); } } }
                if (more) {
#pragma unroll
                    for (int q = 0; q < 2; ++q)
#pragma unroll
                        for (int j = 0; j < 4; ++j) { xw[q][j] = xn[q][j]; ya_[q][j] = yan[q][j]; yb_[q][j] = ybn[q][j]; } }
            }
#undef LN2_LOAD
            }
        }

__device__ __forceinline__ void xcd_barrier_work(const int wv, const bool want_local, const bool work) {
    const int tid_ = wv * 64 + lane_now();
    asm volatile("s_waitcnt vmcnt(0)" ::: "memory");
    __syncthreads();
    volatile LAS int* misc = (volatile LAS int*)((LAS unsigned char*)lds_raw + LC_MISC);
    XcdBarrier b; { kargp_t kq = (kargp_t)__builtin_amdgcn_kernarg_segment_ptr(); asm volatile("" : "+s"(kq)); b.bar = (unsigned*)(kq->ws + WS_CTL) + CW_BAR; b.x = xb_xcc_id(); b.st = (volatile LAS unsigned*)((LAS unsigned char*)lds_raw + LC_MISC) + 8; }
    const unsigned gen_expected = (unsigned)misc[LW_GEN] + 1u;
    __syncthreads();
    if (tid_ < 64) {
        if (tid_ == 0) {
            unsigned* bar = b.bar;
            __builtin_amdgcn_s_waitcnt(0);
            unsigned nloc = b.st[0], nx = b.st[1];
            if (nloc == 0u) { xcd_barrier_complete(bar, b.x, nloc, nx); b.st[0] = nloc; b.st[1] = nx;
                unsigned seen = 0u, okc = (gridDim.x == 256u) ? 1u : 0u;
#pragma unroll
                for (int c = 0; c < 8; ++c) { const unsigned m = xb_ld(&bar[CW_CLS - CW_BAR + c]); okc &= (m != 0u && (m & (m - 1u)) == 0u && (seen & m) == 0u) ? 1u : 0u; seen |= m; }
                b.st[2] = 1u + okc; }
            const bool local = want_local && (b.st[2] == 2u);
            if (local) {
                const unsigned lc = b.st[3] + 1u; b.st[3] = lc;
                (void)__hip_atomic_fetch_add(&bar[XB_XLOC(b.x)], 1u, __ATOMIC_RELAXED, __HIP_MEMORY_SCOPE_AGENT);
                asm volatile("buffer_inv sc1" ::: "memory");
                XB_SPIN(xb_ld(&bar[XB_XLOC(b.x)]) < lc * nloc, bar);
                asm volatile("s_waitcnt vmcnt(0)" ::: "memory");
            } else {
            const unsigned old = xb_add(&bar[XB_XSUB(b.x)], 1u);
            asm volatile("buffer_inv sc1" ::: "memory");
            const unsigned gen = old / nloc;
            if (old + 1u == (gen + 1u) * nloc) {
                __builtin_amdgcn_fence(__ATOMIC_RELEASE, "agent");
                asm volatile("s_waitcnt vmcnt(0)" ::: "memory");
                (void)__hip_atomic_fetch_add(&bar[XB_TOP], 1u, __ATOMIC_RELAXED, __HIP_MEMORY_SCOPE_AGENT);
            }
            XB_SPIN(xb_ld(&bar[XB_TOP]) < (gen + 1u) * nx, bar);
            asm volatile("s_waitcnt vmcnt(0)" ::: "memory");
            }
            misc[LW_REL] = (int)gen_expected;
        }
    } else {
        kargp_t kp = (kargp_t)__builtin_amdgcn_kernarg_segment_ptr(); asm volatile("" : "+s"(kp)); unsigned char* ws = kp->ws;
        const int lane = lane_now(), wave = wv;
        LAS float* scr = (LAS float*)((LAS unsigned char*)lds_raw + wave * 16384);
        bool more = (NREP(16) > 1) ? false : work;
        while (misc[LW_REL] != (int)gen_expected) {
            if (more) more = cq_step(kp, ws, scr, lane, QTOTAL);
            else __builtin_amdgcn_s_sleep(4);
        }
    }
    __syncthreads();
    if (tid_ == 0) misc[LW_GEN] = (int)gen_expected;
}
__device__ __forceinline__ void cq_drain(kargp_t kp, unsigned char* ws, int lmax, const int wv) {
    const int lane = lane_now(), wave = wv;
    LAS float* scr = (LAS float*)((LAS unsigned char*)lds_raw + wave * 16384);
    __syncthreads();
    while (cq_step(kp, ws, scr, lane, lmax * NPL)) {}
    __syncthreads();
}


__global__ void __launch_bounds__(NTHREADS, 2) fwd_kernel(Args args) {
    Frame F;
    F.lds = (LAS unsigned char*)lds_raw;
    const int wv0 = __builtin_amdgcn_readfirstlane(threadIdx.x >> 6);
    F.wave = wv0; F.lane = lane_now(); F.tid = wv0 * 64 + F.lane;
    F.G = gridDim.x; { const int bx = blockIdx.x; F.bid = bx; F.vcu = (F.G % 8 == 0) ? (bx % 8) * (F.G / 8) + bx / 8 : bx; }
    unsigned char* ws = args.ws;
    F.ctl = (gu32*)(ws + WS_CTL);
    for (int u = F.tid; u < (LDS_BYTES - LC_OFF) / 4; u += NTHREADS) ((LAS unsigned*)(F.lds + LC_OFF))[u] = 0u;
    __syncthreads();
    if (F.tid == 0) ((LAS int*)(F.lds + LC_MISC))[LW_Q] = QB;
    __syncthreads();
#if MK_ONE_LAUNCH
    if (F.tid == 0) { (void)__hip_atomic_fetch_or(F.ctl + CW_CLS + (F.bid & 7), 1u << xb_xcc_id(), __ATOMIC_RELAXED, __HIP_MEMORY_SCOPE_AGENT); asm volatile("s_waitcnt vmcnt(0)" ::: "memory"); }
    (void)xcd_barrier_post((unsigned*)(F.ctl + CW_BAR), (volatile LAS unsigned*)(F.lds + LC_MISC) + 8);
#define GRID_BAR() xcd_barrier_work(wv0, false, true)
#define XCD_BAR() xcd_barrier_work(wv0, true, true)
#define XCD_BAR_NW() xcd_barrier_work(wv0, true, false)
#else
#define GRID_BAR() do {} while (0)
#define XCD_BAR() do {} while (0)
#define XCD_BAR_NW() do {} while (0)
#endif
    kargp_t kp = (kargp_t)__builtin_amdgcn_kernarg_segment_ptr();
    const int lo = args.ph_lo, hi = args.ph_hi; (void)ws;
#ifndef PH_MASK
#define PH_MASK 0x1ff
#endif
#define IN(k) (lo <= (k) && (k) < hi)
#define EN(p) ((PH_MASK >> (p)) & 1)

#define FRESH() do { F.wave = wv0; F.lane = lane_now(); F.tid = wv0 * 64 + F.lane; { int bx_ = blockIdx.x; asm volatile("" : "+s"(bx_)); F.bid = bx_; } \
        kp = (kargp_t)__builtin_amdgcn_kernarg_segment_ptr(); asm volatile("" : "+s"(kp)); ws = kp->ws; F.ctl = (gu32*)(ws + WS_CTL); } while (0)
#define SEAM(k) do { if (IN(k) && IN((k) + 1)) GRID_BAR(); } while (0)
#define SEAM_LN(k) do { if (IN(k) && IN((k) + 1)) XCD_BAR_NW(); } while (0)
#define SEAM_L(k) do { if (IN(k) && IN((k) + 1)) XCD_BAR(); } while (0)

    if (EN(8) && IN(0)) for (int rep_ = 0; rep_ < NREP(8); ++rep_) { phase_prologue(wv0); }
    SEAM(0);

    for (int l = 0; l < DEPTH; ++l) {
        const int pb = 1 + 8 * l;
        if (EN(0) && IN(pb + 0)) for (int rep_ = 0; rep_ < (NREP(0) > NREP(11) ? NREP(0) : NREP(11)); ++rep_) { FRESH();
            pg8::SchedStatic S{(const char*)(ws + WS_XF8), (const char*)(ws + WS_WIN) + (size_t)l * NIN * D, T / 256, NIN / 256, F.G, F.bid, (size_t)256 * D};
            pg8::EpiProj E{proj, bias_s + l * NIN, (NREP(11) > 1 && rep_ == 0) ? 1 : 0, (unsigned char*)(ws + WS_GATE)};
            pg8::gemm_phase<D / 2, false, pg8::EpiProj, pg8::SchedStatic, false, true>(F.lds, F.tid, S, E, E_X8, E_W8);
        }
        SEAM_L(pb + 0);
        if (EN(1) && IN(pb + 1)) for (int rep_ = 0; rep_ < NREP(1); ++rep_) {
            phase_attn_mfma(l, wv0);
        }
        SEAM_LN(pb + 1);
        if (EN(2) && IN(pb + 2)) for (int rep_ = 0; rep_ < (NREP(2) > NREP(12) ? NREP(2) : NREP(12)); ++rep_) { FRESH();
            pg8::SchedTwoSeg S{(const char*)(ws + WS_YA), (long)(16 * MiB), (const char*)(ws + WS_WA) + (size_t)l * D * 512, (long)(WS_WB - WS_WA), T / 256, D / 256, F.G, F.bid, (size_t)256 * 512};
            pg8::EpiMerge E{(unsigned char*)(ws + WS_MERGED), (const unsigned char*)(ws + WS_GATE), (NREP(12) > 1 && rep_ == 0) ? 1 : 0};
            pg8::gemm_phase<D / 2, false, pg8::EpiMerge, pg8::SchedTwoSeg, true, true>(F.lds, F.tid, S, E, E_Y8, E_W8);
        }
        SEAM_LN(pb + 2);
        if (EN(3) && IN(pb + 3)) for (int rep_ = 0; rep_ < NREP(3); ++rep_) { FRESH();
            pg8::SchedStatic S{(const char*)(ws + WS_MERGED), (const char*)(ws + WS_WO) + (size_t)l * D * D, T / 256, D / 256, F.G, F.bid, (size_t)256 * D};
            pg8::EpiPlain8 E{(unsigned char*)mix, D, SMX8};
            pg8::gemm_phase<D / 2, false, pg8::EpiPlain8, pg8::SchedStatic, false, true>(F.lds, F.tid, S, E, E_M8, E_W8);
        }
        SEAM_LN(pb + 3);
        if (EN(4) && IN(pb + 4)) { phase_ln1(l, false, wv0); }
        SEAM(pb + 4);
        if (EN(5) && IN(pb + 5)) for (int rep_ = 0; rep_ < NREP(5); ++rep_) { FRESH();
            const int ntiles = moe_tables(F, l);
            pg8::SchedMoe S{(const char*)(ws + WS_XF8), (const char*)(ws + WS_WGU) + (size_t)l * NE * 1024 * D, tok, (const LAS int*)(F.lds + LC_T2E), (const LAS int*)(F.lds + LC_TSTART), (const LAS int*)(F.lds + LC_CNT), ntiles, F.G, F.vcu,
                            0, (size_t)1024 * D, (size_t)256 * D, D};
            pg8::EpiSwiglu E{(unsigned char*)(ws + WS_H)};
            pg8::gemm_phase<D / 2, true, pg8::EpiSwiglu, pg8::SchedMoe, false, true>(F.lds, F.tid, S, E, E_X8, E_W8);
        }
        SEAM_LN(pb + 5);
        if (EN(6) && IN(pb + 6)) for (int rep_ = 0; rep_ < NREP(6); ++rep_) { FRESH();
            const int ntiles = moe_tables_cached(F, l);
            pg8::SchedMoe S{(const char*)(ws + WS_H), (const char*)(ws + WS_WD) + (size_t)l * NE * D * DE, tok, (const LAS int*)(F.lds + LC_T2E), (const LAS int*)(F.lds + LC_TSTART), (const LAS int*)(F.lds + LC_CNT), ntiles, F.G, F.vcu,
                            (size_t)256 * DE, (size_t)D * DE, (size_t)256 * DE, DE};
            pg8::EpiPlain8 E{(unsigned char*)(ws + WS_Y2), D, SY28};
            pg8::gemm_phase<DE / 2, false, pg8::EpiPlain8, pg8::SchedMoe, false, true>(F.lds, F.tid, S, E, E_H8, E_W8);
        }
#if MK_ONE_LAUNCH
        if (EN(6) && IN(pb + 6) && l + 1 < DEPTH) { FRESH(); cq_drain(kp, ws, l + 1, wv0); }
#endif
        SEAM(pb + 6);
        if (EN(7) && IN(pb + 7)) { phase_ln2(l, false, wv0); }
        SEAM_LN(pb + 7);
    }
#undef IN
#undef SEAM
}


extern "C" void kernel_launch(void* const* d_in, const int* in_sizes, int n_in, void* d_out, int out_size, void* d_ws, size_t ws_size, hipStream_t stream) {
    static int grid = 0;
    if (grid == 0) {
        if (n_in != 16 || in_sizes[0] != T * D || out_size != T * D || ws_size < WS_END) { fprintf(stderr, "kernel_launch: unexpected shapes (n_in %d, in0 %d, out %d, ws %zu < %zu)\n", n_in, n_in > 0 ? in_sizes[0] : -1, out_size, ws_size, (size_t)WS_END); grid = -1; return; }
        int dev = 0, cus = 0, per_cu = 0;
        if (hipGetDevice(&dev) != hipSuccess || hipDeviceGetAttribute(&cus, hipDeviceAttributeMultiprocessorCount, dev) != hipSuccess) { grid = -1; return; }
        if (hipFuncSetAttribute((const void*)fwd_kernel, hipFuncAttributeMaxDynamicSharedMemorySize, LDS_BYTES) != hipSuccess) { fprintf(stderr, "kernel_launch: hipFuncSetAttribute failed\n"); grid = -1; return; }
        if (hipOccupancyMaxActiveBlocksPerMultiprocessor(&per_cu, (const void*)fwd_kernel, NTHREADS, LDS_BYTES) != hipSuccess || per_cu < 1) fprintf(stderr, "kernel_launch: occupancy query reports %d\n", per_cu);
        (void)hipGetLastError();
        grid = cus;
    }
    if (grid < 0) return;
    (void)hipMemsetAsync((char*)d_ws + WS_CTL, 0, CTL_ZERO_BYTES, stream);
    Args a{};
    for (int i = 0; i < 16; ++i) a.in[i] = (const float*)d_in[i];
    a.out = (float*)d_out; a.ws = (unsigned char*)d_ws;
#if MK_ONE_LAUNCH
    a.ph_lo = 0; a.ph_hi = N_PHASES;
    hipLaunchKernelGGL(fwd_kernel, dim3(grid), dim3(NTHREADS), LDS_BYTES, stream, a);
#else
    for (int p = 0; p < N_PHASES; ++p) { a.ph_lo = p; a.ph_hi = p + 1; hipLaunchKernelGGL(fwd_kernel, dim3(grid), dim3(NTHREADS), LDS_BYTES, stream, a);
    }
#endif
}
```

```cpp
#include <hip/hip_runtime.h>
#include <cstdio>
#include <cstdint>

#ifndef MK_ONE_LAUNCH
#define MK_ONE_LAUNCH 1
#endif
#ifndef DIAG
#define DIAG 0
#define REP_MASK 0x000
#define NREP(p) (((REP_MASK >> (p)) & 1) ? 2 : 1)
#endif

#define LAS __attribute__((address_space(3)))
#define GAS __attribute__((address_space(1)))
typedef unsigned short bf16_t;
typedef short bf16x8 __attribute__((ext_vector_type(8)));
typedef float f32x4 __attribute__((ext_vector_type(4)));
typedef float f32x2 __attribute__((ext_vector_type(2)));
typedef unsigned u32x4 __attribute__((ext_vector_type(4)));
typedef unsigned u32x2 __attribute__((ext_vector_type(2)));
typedef GAS unsigned gu32;

constexpr int D = 1024, BATCH = 16, SEQ = 2048, T = BATCH * SEQ, DEPTH = 4;
constexpr int NIN = 4352, NE = 32, DE = 512;
constexpr int PP = 2304;
constexpr int C_AQ = 0, C_AK = 512, C_AV = 640, C_SQ = 768, C_SK = 1280, C_SV = 1792, C_GA = 2304, C_GB = 3328;
constexpr float LN_EPS = 1e-5f;
constexpr float ALPHA = 1.6817928305074290f;
constexpr float LOG2E = 1.4426950408889634f;
constexpr float C2 = 0.125f * LOG2E;
constexpr int TOKCAP = T;
constexpr int MAXTILES = T * 2 / 256 + NE;

constexpr size_t MiB = 1u << 20;
constexpr size_t WS_CTL = 0, CTL_ZERO_BYTES = 1 * MiB;
constexpr size_t WS_BIAS = 1 * MiB;
constexpr size_t WS_WIN = 2 * MiB;
constexpr size_t WS_WA = 36 * MiB, WS_WB = 40 * MiB;
constexpr size_t WS_WO = 44 * MiB;
constexpr size_t WS_WGU = 52 * MiB;
constexpr size_t WS_WD = 308 * MiB;
constexpr size_t WS_XB = 436 * MiB;
constexpr size_t WS_PROJ = 500 * MiB;
constexpr size_t WS_GATE = 644 * MiB;
constexpr size_t WS_H = 500 * MiB;
constexpr size_t WS_Y2 = 906 * MiB;
constexpr size_t WS_YA = 772 * MiB, WS_YB = 804 * MiB;
constexpr size_t WS_MIX = 180 * MiB;
constexpr size_t WS_MERGED = 836 * MiB;
constexpr size_t WS_XF8 = WS_MERGED + 32 * MiB;
constexpr float SMX8 = 32.f;
constexpr float SX8 = 8.f, SW8 = 64.f, SY8 = 64.f, SM8 = 128.f, SH8 = 16.f, SG8 = 256.f, SY28 = 128.f;
constexpr int E_X8 = 0x01010101 * (127 - 3), E_W8 = 0x01010101 * (127 - 6), E_Y8 = 0x01010101 * (127 - 6), E_M8 = 0x01010101 * (127 - 7), E_H8 = 0x01010101 * (127 - 4);
constexpr size_t WS_TOK = 900 * MiB;
constexpr size_t WS_SLOT = 904 * MiB;
constexpr size_t WS_END = 978 * MiB;
static_assert(WS_WIN + (size_t)DEPTH * NIN * D * 2 <= WS_WA && WS_WGU + (size_t)DEPTH * NE * 1024 * D * 2 <= WS_WD && WS_WD + (size_t)DEPTH * NE * D * 512 * 2 <= WS_XB, "ws map");
static_assert(WS_Y2 + (size_t)MAXTILES * 256 * D <= WS_END && WS_PROJ + (size_t)T * PP * 2 <= WS_GATE && WS_GATE + (size_t)2 * T * D * 2 <= WS_YA && WS_H + (size_t)MAXTILES * 256 * 512 * 2 <= WS_Y2 && WS_WGU + (size_t)DEPTH * NE * 1024 * D <= WS_MIX && WS_MIX + (size_t)T * D * 2 <= WS_WD && WS_H + (size_t)MAXTILES * 256 * 512 <= WS_GATE, "ws map 2");
constexpr int CW_CLS = 8192;
constexpr int CW_TMO = 0, CW_CODE = 1, CW_BAR = 4096, CW_CNT = 16384;

constexpr int RING_BYTES = 131072;
constexpr int LC_OFF = 132096;
constexpr int LC_MISC = LC_OFF + 0;
constexpr int LC_HIST = LC_OFF + 256, LC_BASE = LC_OFF + 384, LC_CNT = LC_OFF + 512, LC_TSTART = LC_OFF + 704;
constexpr int LC_T2E = LC_OFF + 1024;
constexpr int LC_SE = LC_OFF + 2560, LC_SR = LC_SE + 1024, LC_SG = LC_SR + 1024;
constexpr int LC_LOGIT = LC_OFF + 5632;
constexpr int LC_GB = LC_OFF + 22528;
constexpr int LC_RB = LC_GB + 8192;
constexpr int LDS_BYTES = LC_RB + 128;
static_assert(LC_SG + 1024 <= LC_LOGIT && LC_LOGIT + 128 * 33 * 4 <= LC_GB && LDS_BYTES <= 160 * 1024 && LC_T2E + MAXTILES * 4 <= LC_SE && 32 * 1028 * 4 <= LC_OFF, "LDS map");

constexpr int NWAVES = 8, NTHREADS = 512;

__device__ __forceinline__ unsigned cvt_pk_bf16(float lo, float hi) { unsigned r; asm volatile("v_cvt_pk_bf16_f32 %0, %1, %2" : "=v"(r) : "v"(lo), "v"(hi)); return r; }
__device__ __forceinline__ float bf_lo(unsigned u) { return __uint_as_float(u << 16); }
__device__ __forceinline__ float bf_hi(unsigned u) { return __uint_as_float(u & 0xffff0000u); }
__device__ __forceinline__ int lane_now() { int l_; asm volatile("v_mbcnt_lo_u32_b32 %0, -1, 0\n\tv_mbcnt_hi_u32_b32 %0, -1, %0" : "=v"(l_)); return l_; }
__device__ __forceinline__ unsigned pk4_fp8(float a, float b, float c, float d) {
    int w = __builtin_amdgcn_cvt_pk_fp8_f32(a, b, 0, false); w = __builtin_amdgcn_cvt_pk_fp8_f32(c, d, w, true); return (unsigned)w; }
__device__ __forceinline__ float wave_sum(float x) {
    x += __int_as_float(__builtin_amdgcn_update_dpp(0, __float_as_int(x), 0xB1, 0xf, 0xf, false));
    x += __int_as_float(__builtin_amdgcn_update_dpp(0, __float_as_int(x), 0x4E, 0xf, 0xf, false));
    x += __int_as_float(__builtin_amdgcn_update_dpp(0, __float_as_int(x), 0x141, 0xf, 0xf, false));
    x += __int_as_float(__builtin_amdgcn_update_dpp(0, __float_as_int(x), 0x140, 0xf, 0xf, false));
    { const unsigned u = __float_as_uint(x); auto r = __builtin_amdgcn_permlane16_swap(u, u, false, false); x = __uint_as_float(r[0]) + __uint_as_float(r[1]); }
    { const unsigned u = __float_as_uint(x); auto r = __builtin_amdgcn_permlane32_swap(u, u, false, false); x = __uint_as_float(r[0]) + __uint_as_float(r[1]); }
    return x;
}
__device__ __forceinline__ float shx(float v, int o, int lane) { return __int_as_float(__builtin_amdgcn_ds_bpermute((lane ^ o) << 2, __float_as_int(v))); }
__device__ __forceinline__ float fast_exp2(float x) { return __builtin_amdgcn_exp2f(x); }
__device__ __forceinline__ float fast_rcp(float x) { return __builtin_amdgcn_rcpf(x); }
__device__ __forceinline__ float sigmoidf_(float x) { return 1.0f / (1.0f + __expf(-x)); }

#define XB_TMO      128
#define XB_XCNT(j)  (256  + 64 * (j))
#define XB_XSUB(j)  (1280 + 64 * (j))
#define XB_XGEN(j)  (2304 + 64 * (j))
#define XB_XLOC(j)  (4160 + 64 * (j))
#define XB_TOP      3328
#define XB_TOPGEN   3392
#define XCD_BAR_WORDS 3456
#define XB_SPIN_CAP (1u << 18)
__device__ __forceinline__ unsigned xb_ld(unsigned* p)              { return __hip_atomic_load(p, __ATOMIC_RELAXED, __HIP_MEMORY_SCOPE_AGENT); }
__device__ __forceinline__ unsigned xb_add(unsigned* p, unsigned v) { return __hip_atomic_fetch_add(p, v, __ATOMIC_RELAXED, __HIP_MEMORY_SCOPE_AGENT); }
__device__ __forceinline__ unsigned xb_xcc_id() { return (unsigned)__builtin_amdgcn_s_getreg((3 << 11) | 20) & 0xFu; }
#define XB_SPIN(cond, bar) do { unsigned _sp = 0; while (cond) { __builtin_amdgcn_s_sleep(1); \
    if ((++_sp & 255u) == 0u) { if (xb_ld(&(bar)[XB_TMO])) break; if (_sp > XB_SPIN_CAP) { atomicAdd(&(bar)[XB_TMO], 1u); break; } } } } while (0)
struct XcdBarrier { unsigned* bar; unsigned x; volatile LAS unsigned* st; };
__device__ __forceinline__ XcdBarrier xcd_barrier_post(unsigned* bar, volatile LAS unsigned* st) {
    XcdBarrier b; b.bar = bar; b.x = xb_xcc_id(); b.st = st;
    if (threadIdx.x == 0) (void)xb_add(&bar[XB_XCNT(b.x)], 1u);
    return b;
}
__device__ __forceinline__ void xcd_barrier_complete(unsigned* bar, unsigned x, unsigned& nloc, unsigned& nx) {
    const unsigned G = gridDim.x * gridDim.y * gridDim.z;
    unsigned sum, cnt, mine, sp = 0u;
    for (;;) {
        sum = 0u; cnt = 0u; mine = 0u;
#pragma unroll
        for (unsigned j = 0; j < 16; ++j) { const unsigned c = xb_ld(&bar[XB_XCNT(j)]); sum += c; cnt += (c > 0u) ? 1u : 0u; mine = (j == x) ? c : mine; }
        if (sum == G) break;
        __builtin_amdgcn_s_sleep(1);
        if ((++sp & 255u) == 0u) { if (xb_ld(&bar[XB_TMO])) break; if (sp > XB_SPIN_CAP) { atomicAdd(&bar[XB_TMO], 1u); break; } }
    }
    nloc = mine > 0u ? mine : 1u; nx = cnt > 0u ? cnt : 1u;
}
__device__ __forceinline__ void xcd_barrier(const XcdBarrier& b) {
    asm volatile("s_waitcnt vmcnt(0)" ::: "memory");
    __syncthreads();
    if (threadIdx.x == 0) {
        unsigned* bar = b.bar;
        __builtin_amdgcn_s_waitcnt(0);
        unsigned nloc = b.st[0], nx = b.st[1];
        if (nloc == 0u) { xcd_barrier_complete(bar, b.x, nloc, nx); b.st[0] = nloc; b.st[1] = nx; }
        const unsigned old = xb_add(&bar[XB_XSUB(b.x)], 1u);
        const unsigned gen = old / nloc;
        if (old + 1u == (gen + 1u) * nloc) {
            __builtin_amdgcn_fence(__ATOMIC_RELEASE, "agent");
            asm volatile("s_waitcnt vmcnt(0)" ::: "memory");
            const unsigned og = xb_add(&bar[XB_TOP], 1u);
            const unsigned tg = og / nx;
            if (og + 1u == (tg + 1u) * nx) xb_add(&bar[XB_TOPGEN], 1u);
            else XB_SPIN(xb_ld(&bar[XB_TOPGEN]) == tg, bar);
            __builtin_amdgcn_fence(__ATOMIC_ACQUIRE, "agent");
            xb_add(&bar[XB_XGEN(b.x)], 1u);
            asm volatile("s_waitcnt vmcnt(0)" ::: "memory");
        } else {
            XB_SPIN(xb_ld(&bar[XB_XGEN(b.x)]) == gen, bar);
            __builtin_amdgcn_fence(__ATOMIC_ACQUIRE, "agent");
            asm volatile("s_waitcnt vmcnt(0)" ::: "memory");
        }
    }
    __syncthreads();
}

namespace pg8 {
constexpr int BM = 256, BK = 64, HALF = 128, HTB = HALF * BK * 2, STAGE_BYTES = 8 * HTB, NXCD = 8, WGM = 8;
__host__ __device__ __forceinline__ int lds_byte(int r, int c) { const int st = (r >> 4) * 2 + (c >> 5), rr = r & 15, cc = c & 31, ob = rr * 64 + cc * 2; return st * 1024 + (ob ^ (((ob >> 9) & 1) << 5)); }
__host__ __device__ __forceinline__ void stage_rc(int b, int& R, int& C) { const int st = b / 1024, sb = b % 1024, swz = sb ^ (((sb >> 9) & 1) << 5); R = (st >> 1) * 16 + swz / 64; C = (st & 1) * 32 + (swz % 64) / 2; }
__host__ __device__ __forceinline__ int perm32(int rho) { const int n = rho >> 4, i = rho & 15; return 8 * (i >> 2) + 4 * n + (i & 3); }

struct Unit { int pm, pn, aux; };

__device__ __forceinline__ bool static_tile(int nM, int nN, int G, int c, int i, int& pm, int& pn) {
    const int nwg = nM * nN; const long L = (long)i * G + c; if (L >= nwg) return false;
    int wgid = (int)L; { const int q = nwg / NXCD, r = nwg % NXCD, xcd = wgid % NXCD, off = wgid / NXCD; wgid = (xcd < r ? xcd * (q + 1) : r * (q + 1) + (xcd - r) * q) + off; }
    const int nig = WGM * nN, gid = wgid / nig, fm = gid * WGM, gsz = (nM - fm) < WGM ? (nM - fm) : WGM;
    pm = fm + ((wgid % nig) % gsz); pn = (wgid % nig) / gsz; return true;
}

template <int K, bool GATHER, class Epi, class Sched, bool TWOSEG = false, bool FP8 = false>
__device__ __forceinline__ void gemm_phase(LAS unsigned char* lds, const int tid, const Sched& S, const Epi& E, const int sc_a = 0x7f7f7f7f, const int sc_b = 0x7f7f7f7f) {
    const int wid = __builtin_amdgcn_readfirstlane(tid >> 6), lane = tid & 63, wr = wid >> 2, wc = wid & 3, fr = lane & 15, fq = lane >> 4;
    constexpr int nt = K / BK;
    constexpr int LD = TWOSEG ? K / 2 : K;
    static_assert(K % 128 == 0 && K >= 256 && (!TWOSEG || (nt % 4 == 0 && !GATHER)), "K");
    int Rr[2], Cc[2]; unsigned voffB[2];
#pragma unroll
    for (int i = 0; i < 2; ++i) { int R, C; stage_rc(tid * 16 + i * 8192, R, C); const int Rb = (R & ~31) + perm32(R & 31); Rr[i] = R; Cc[i] = C; voffB[i] = (unsigned)(Rb * LD + C) * 2u; }
    constexpr size_t kstep = (size_t)(BK * 2);
    constexpr size_t hstepB = (size_t)HALF * LD * 2;
    constexpr size_t hstepA = GATHER ? 0 : (size_t)HALF * LD * 2;
    const unsigned ldsw = (unsigned)wid * 1024u; const unsigned ldsbase = (unsigned)(uintptr_t)lds;
    const int aoff = lds_byte(wr * 64 + fr, fq * 8), boff = lds_byte(wc * 32 + fr, fq * 8);
#define PG8_SA(b, h) (((b) * 2 + (h)) * HTB)
#define PG8_SB(b, h) ((4 + (b) * 2 + (h)) * HTB)
#define PG8_STAGE(bufoff, gbase, voff) do { _Pragma("unroll") for (int _i = 0; _i < 2; ++_i) { \
        if constexpr (FP8 || GATHER) { unsigned keep_; asm volatile("s_mov_b32 %0, m0\n\ts_mov_b32 m0, %3\n\ts_nop 0\n\tglobal_load_lds_dwordx4 %1, %2\n\ts_mov_b32 m0, %0" : "=&s"(keep_) : "v"((voff)[_i]), "s"((const char*)(gbase)), \
                     "s"((unsigned)__builtin_amdgcn_readfirstlane((int)(ldsbase + (unsigned)(bufoff) + ldsw + _i * 8192u))) : "memory"); } \
        else __builtin_amdgcn_global_load_lds((const unsigned*)((const char*)(gbase) + (voff)[_i]), (LAS unsigned*)(lds + (bufoff) + ldsw + _i * 8192), 16, 0, 0); } } while (0)
    typedef int v8i_ __attribute__((ext_vector_type(8))); typedef int v4i_ __attribute__((ext_vector_type(4)));
#define PG8_LDA(dst, b, h) do { _Pragma("unroll") for (int m = 0; m < 4; ++m) { \
        if constexpr (FP8) { const v4i_ lo_ = *(const LAS v4i_*)(lds + PG8_SA(b, h) + aoff + m * 2048), hi_ = *(const LAS v4i_*)(lds + PG8_SA(b, h) + aoff + m * 2048 + 1024); dst##8[m] = __builtin_shufflevector(lo_, hi_, 0, 1, 2, 3, 4, 5, 6, 7); } \
        else { _Pragma("unroll") for (int k = 0; k < 2; ++k) dst[m][k] = *(const LAS bf16x8*)(lds + PG8_SA(b, h) + aoff + m * 2048 + k * 1024); } } } while (0)
#define PG8_LDB(dst, b, h) do { _Pragma("unroll") for (int n = 0; n < 2; ++n) { \
        if constexpr (FP8) { const v4i_ lo_ = *(const LAS v4i_*)(lds + PG8_SB(b, h) + boff + n * 2048), hi_ = *(const LAS v4i_*)(lds + PG8_SB(b, h) + boff + n * 2048 + 1024); dst##8[n] = __builtin_shufflevector(lo_, hi_, 0, 1, 2, 3, 4, 5, 6, 7); } \
        else { _Pragma("unroll") for (int k = 0; k < 2; ++k) dst[n][k] = *(const LAS bf16x8*)(lds + PG8_SB(b, h) + boff + n * 2048 + k * 1024); } } } while (0)
#define PG8_MMA(ai, bj, At, Bt) do { __builtin_amdgcn_s_setprio(1); _Pragma("unroll") for (int m = 0; m < 4; ++m) _Pragma("unroll") for (int n = 0; n < 2; ++n) { \
        if constexpr (FP8) acc[ai][bj][m][n] = __builtin_amdgcn_mfma_scale_f32_16x16x128_f8f6f4(Bt##8[n], At##8[m], acc[ai][bj][m][n], 0, 0, 0, sc_b, 0, sc_a); \
        else { _Pragma("unroll") for (int k = 0; k < 2; ++k) acc[ai][bj][m][n] = __builtin_amdgcn_mfma_f32_16x16x32_bf16(Bt[n][k], At[m][k], acc[ai][bj][m][n], 0, 0, 0); } } \
        __builtin_amdgcn_s_setprio(0); } while (0)
#define PG8_WAIT_V(n) asm volatile("s_waitcnt vmcnt(" #n ")" ::: "memory")
#define PG8_WAIT_L(n) asm volatile("s_waitcnt lgkmcnt(" #n ")" ::: "memory")
#define PG8_BAR __builtin_amdgcn_s_barrier()
#define PG8_SCHED __builtin_amdgcn_sched_barrier(0)
    Unit cur, nxt; int ui = 0;
    if (!S.next(0, cur)) return;
    unsigned voffA[2][2], nvoffA[2][2];
    if constexpr (GATHER) {
        S.gather_issue(cur, Rr, voffA);
        asm volatile("s_waitcnt vmcnt(0)" : "+v"(voffA[0][0]), "+v"(voffA[0][1]), "+v"(voffA[1][0]), "+v"(voffA[1][1]) :: "memory");
#pragma unroll
        for (int h = 0; h < 2; ++h)
#pragma unroll
            for (int i = 0; i < 2; ++i) voffA[h][i] = S.gather_finish(voffA[h][i], Cc[i]);
    }
    else {
#pragma unroll
        for (int h = 0; h < 2; ++h)
#pragma unroll
            for (int i = 0; i < 2; ++i) voffA[h][i] = (unsigned)(Rr[i] * LD + Cc[i]) * 2u;
    }
    f32x4 acc[2][2][4][2];
#pragma unroll
    for (int a = 0; a < 2; ++a)
#pragma unroll
        for (int b = 0; b < 2; ++b)
#pragma unroll
            for (int m = 0; m < 4; ++m)
#pragma unroll
                for (int n = 0; n < 2; ++n) { f32x4 z_; asm volatile("v_mov_b32 %0, 0\n\tv_mov_b32 %1, 0\n\tv_mov_b32 %2, 0\n\tv_mov_b32 %3, 0" : "=v"(z_[0]), "=v"(z_[1]), "=v"(z_[2]), "=v"(z_[3])); acc[a][b][m][n] = z_; }
    const char* cA = S.abase(cur); const char* cB = S.bbase(cur);
    PG8_STAGE(PG8_SB(0, 0), cB, voffB); PG8_STAGE(PG8_SB(0, 1), cB + hstepB, voffB); PG8_STAGE(PG8_SA(0, 0), cA, voffA[0]); PG8_STAGE(PG8_SA(0, 1), cA + hstepA, voffA[1]);
    if (wr == 1) PG8_BAR;
    PG8_WAIT_V(2); PG8_BAR;
    PG8_STAGE(PG8_SB(1, 0), cB + kstep, voffB); PG8_STAGE(PG8_SA(1, 0), cA + kstep, voffA[0]); PG8_STAGE(PG8_SB(1, 1), cB + hstepB + kstep, voffB);
    PG8_WAIT_V(6); PG8_BAR;
    for (;;) {
        const bool has_next = S.next(ui + 1, nxt);
        const char* nA = has_next ? S.abase(nxt) : cA; const char* nB = has_next ? S.bbase(nxt) : cB;
        if constexpr (GATHER) {
            if (has_next) S.gather_issue(nxt, Rr, nvoffA);
        }
#pragma unroll 1
        for (int t = 0; t < nt; t += 2) {
            const bool last = (t == nt - 2);
            bf16x8 At[4][2], B0[2][2], B1[2][2]; v8i_ At8[4], B08[2], B18[2];
            (void)At; (void)B0; (void)B1; (void)At8; (void)B08; (void)B18;
            long sA1 = 0, sA2 = 0, sB2 = 0;
            if constexpr (TWOSEG) { if (t + 1 >= nt / 2) sA1 = S.adiff - (long)(nt / 2) * (long)kstep; if (t + 2 >= nt / 2) { sA2 = S.adiff - (long)(nt / 2) * (long)kstep; sB2 = S.bdiff - (long)(nt / 2) * (long)kstep; } }
            const char* a1 = cA + (size_t)(t + 1) * kstep + sA1;
            const char* a2 = last ? nA : cA + (size_t)(t + 2) * kstep + sA2; const char* b2 = last ? nB : cB + (size_t)(t + 2) * kstep + sB2;
            const char* a3 = a2 + kstep; const char* b3 = b2 + kstep;
            PG8_LDB(B0, 0, 0); PG8_LDB(B1, 0, 1); PG8_SCHED; PG8_LDA(At, 0, 0); PG8_STAGE(PG8_SA(1, 1), a1 + hstepA, voffA[1]);
            if constexpr (GATHER) { if (last) {
#pragma unroll
                for (int h = 0; h < 2; ++h)
#pragma unroll
                    for (int i = 0; i < 2; ++i) { if (has_next) voffA[h][i] = S.gather_finish(nvoffA[h][i], Cc[i]); }
            } }
            PG8_WAIT_V(8); PG8_WAIT_L(0); PG8_BAR; PG8_MMA(0, 0, At, B0); PG8_MMA(0, 1, At, B1); PG8_BAR; PG8_SCHED;
            PG8_LDA(At, 0, 1); PG8_STAGE(PG8_SB(0, 0), b2, voffB); PG8_STAGE(PG8_SB(0, 1), b2 + hstepB, voffB); PG8_STAGE(PG8_SA(0, 0), a2, voffA[0]);
            PG8_WAIT_V(8); PG8_WAIT_L(0); PG8_BAR; PG8_MMA(1, 0, At, B0); PG8_MMA(1, 1, At, B1); PG8_BAR; PG8_SCHED;
            PG8_LDB(B0, 1, 0); PG8_LDB(B1, 1, 1); PG8_SCHED; PG8_LDA(At, 1, 0); PG8_STAGE(PG8_SA(0, 1), a2 + hstepA, voffA[1]);
            PG8_WAIT_V(8); PG8_WAIT_L(0); PG8_BAR; PG8_MMA(0, 0, At, B0); PG8_MMA(0, 1, At, B1); PG8_BAR; PG8_SCHED;
            PG8_LDA(At, 1, 1); PG8_STAGE(PG8_SB(1, 0), b3, voffB); PG8_STAGE(PG8_SB(1, 1), b3 + hstepB, voffB); PG8_STAGE(PG8_SA(1, 0), a3, voffA[0]);
            PG8_WAIT_V(8); PG8_WAIT_L(0); PG8_BAR; PG8_MMA(1, 0, At, B0); PG8_MMA(1, 1, At, B1); PG8_BAR; PG8_SCHED;
            if constexpr (TWOSEG) { if (t == nt / 2 - 2) { const int l2_ = lane_now(); E.mid(acc, cur, wr, wc, l2_ & 15, l2_ >> 4); } }
        }
        if (wr == 0) PG8_BAR;
        { const int l2_ = lane_now(); E(acc, cur, wr, wc, l2_ & 15, l2_ >> 4); }
        if (!has_next) break;
#pragma unroll
        for (int a = 0; a < 2; ++a)
#pragma unroll
            for (int b = 0; b < 2; ++b)
#pragma unroll
                for (int m = 0; m < 4; ++m)
#pragma unroll
                    for (int n = 0; n < 2; ++n) { f32x4 z_; asm volatile("v_mov_b32 %0, 0\n\tv_mov_b32 %1, 0\n\tv_mov_b32 %2, 0\n\tv_mov_b32 %3, 0" : "=v"(z_[0]), "=v"(z_[1]), "=v"(z_[2]), "=v"(z_[3])); acc[a][b][m][n] = z_; }
        cur = nxt; cA = nA; cB = nB; ++ui;
        if (wr == 1) PG8_BAR;
    }
    PG8_WAIT_V(0);
    PG8_BAR;
#undef PG8_SA
#undef PG8_SB
#undef PG8_STAGE
#undef PG8_LDA
#undef PG8_LDB
#undef PG8_MMA
#undef PG8_WAIT_V
#undef PG8_WAIT_L
#undef PG8_BAR
#undef PG8_SCHED
}

struct EpiProj {
    bf16_t* O; const float* bias; int nostore; unsigned char* G;
    __device__ __forceinline__ void operator()(const f32x4 (&acc)[2][2][4][2], const Unit& u, int wr, int wc, int fr, int fq) const {
        if (nostore) return;
        const int row0 = u.pm * BM + wr * 64 + fr, col0 = u.pn * BM + wc * 32 + 8 * fq;
        const bool sig = (u.pn * BM >= C_GA);
        const int gt = sig ? u.pn - C_GA / BM : 0;
        int lo_ = ((wr * 4 + wc) * 64 + fq * 16 + fr) * 8; asm volatile("" : "+v"(lo_));
        unsigned char* gbase = G + ((size_t)((gt >> 2) * (T / BM) + u.pm) * 4 + (gt & 3)) * (BM * BM) + (size_t)lo_;
        f32x4 bz0[2], bz1[2];
#pragma unroll
        for (int bj = 0; bj < 2; ++bj) { bz0[bj] = *(const f32x4*)(bias + col0 + bj * HALF); bz1[bj] = *(const f32x4*)(bias + col0 + bj * HALF + 4); }
#pragma unroll
        for (int ai = 0; ai < 2; ++ai)
#pragma unroll
            for (int m = 0; m < 4; ++m) { bf16_t* rowp = O + (size_t)(row0 + ai * HALF + m * 16) * PP + col0;
#pragma unroll
                for (int bj = 0; bj < 2; ++bj) { f32x4 v0 = acc[ai][bj][m][0] + bz0[bj], v1 = acc[ai][bj][m][1] + bz1[bj];
                    if (sig) {
#pragma unroll
                        for (int q = 0; q < 4; ++q) { v0[q] = fast_rcp(1.0f + fast_exp2(-LOG2E * v0[q])); v1[q] = fast_rcp(1.0f + fast_exp2(-LOG2E * v1[q])); }
                    }
                    if (sig) { u32x2 w8; w8.x = pk4_fp8(v0[0] * SG8, v0[1] * SG8, v0[2] * SG8, v0[3] * SG8); w8.y = pk4_fp8(v1[0] * SG8, v1[1] * SG8, v1[2] * SG8, v1[3] * SG8); *(u32x2*)(gbase + (size_t)(((ai * 4 + m) * 2 + bj) * 4096)) = w8; }
                    else { u32x4 w; w.x = cvt_pk_bf16(v0[0], v0[1]); w.y = cvt_pk_bf16(v0[2], v0[3]); w.z = cvt_pk_bf16(v1[0], v1[1]); w.w = cvt_pk_bf16(v1[2], v1[3]); *(u32x4*)(rowp + bj * HALF) = w; } }  asm volatile("" ::: "memory"); }
    }
};
struct EpiPlain {
    bf16_t* O; int ldc;
    __device__ __forceinline__ void operator()(const f32x4 (&acc)[2][2][4][2], const Unit& u, int wr, int wc, int fr, int fq) const {
        const int row0 = u.pm * BM + wr * 64 + fr, col0 = u.pn * BM + wc * 32 + 8 * fq;
#pragma unroll
        for (int ai = 0; ai < 2; ++ai)
#pragma unroll
            for (int m = 0; m < 4; ++m) { bf16_t* rowp = O + (size_t)(row0 + ai * HALF + m * 16) * ldc + col0;
#pragma unroll
                for (int bj = 0; bj < 2; ++bj) { const f32x4 v0 = acc[ai][bj][m][0], v1 = acc[ai][bj][m][1];
                    u32x4 w; w.x = cvt_pk_bf16(v0[0], v0[1]); w.y = cvt_pk_bf16(v0[2], v0[3]); w.z = cvt_pk_bf16(v1[0], v1[1]); w.w = cvt_pk_bf16(v1[2], v1[3]);
                    *(u32x4*)(rowp + bj * HALF) = w; }  asm volatile("" ::: "memory"); }
    }
};
struct EpiPlain8 {
    unsigned char* O; int ldc; float sc;
    __device__ __forceinline__ void operator()(const f32x4 (&acc)[2][2][4][2], const Unit& u, int wr, int wc, int fr, int fq) const {
        const int row0 = u.pm * BM + wr * 64 + fr, col0 = u.pn * BM + wc * 32 + 8 * fq;
#pragma unroll
        for (int ai = 0; ai < 2; ++ai)
#pragma unroll
            for (int m = 0; m < 4; ++m) { unsigned char* rowp = O + (size_t)(row0 + ai * HALF + m * 16) * ldc + col0;
#pragma unroll
                for (int bj = 0; bj < 2; ++bj) { const f32x4 v0 = acc[ai][bj][m][0], v1 = acc[ai][bj][m][1];
                    u32x2 w; w.x = pk4_fp8(v0[0] * sc, v0[1] * sc, v0[2] * sc, v0[3] * sc); w.y = pk4_fp8(v1[0] * sc, v1[1] * sc, v1[2] * sc, v1[3] * sc);
                    *(u32x2*)(rowp + bj * HALF) = w; } asm volatile("" ::: "memory"); }
    }
};
struct EpiMerge {
    unsigned char* O; const unsigned char* G; int nostore;
    static __device__ __forceinline__ void dec8(const u32x2 g, float (&f)[8]) {
        const f32x2 a = __builtin_amdgcn_cvt_pk_f32_fp8((int)g.x, false), b = __builtin_amdgcn_cvt_pk_f32_fp8((int)g.x, true), c = __builtin_amdgcn_cvt_pk_f32_fp8((int)g.y, false), d = __builtin_amdgcn_cvt_pk_f32_fp8((int)g.y, true);
        f[0] = a[0]; f[1] = a[1]; f[2] = b[0]; f[3] = b[1]; f[4] = c[0]; f[5] = c[1]; f[6] = d[0]; f[7] = d[1]; }
    __device__ __forceinline__ void mid(f32x4 (&acc)[2][2][4][2], const Unit& u, int wr, int wc, int fr, int fq) const {
        if (nostore) return;
        int lo = ((wr * 4 + wc) * 64 + fq * 16 + fr) * 8;
        asm volatile("" : "+v"(lo));
        const unsigned char* ga_p = G + ((size_t)u.pm * 4 + u.pn) * (BM * BM) + lo; const unsigned char* gb_p = ga_p + (size_t)(T / BM) * 4 * (BM * BM);
#pragma unroll
        for (int ai = 0; ai < 2; ++ai) {
            u32x2 gav[8], gbv[8];
#pragma unroll
            for (int i = 0; i < 8; ++i) { const int po = (ai * 8 + i) * 4096; gav[i] = *(const u32x2*)(ga_p + po); gbv[i] = *(const u32x2*)(gb_p + po); }
#pragma unroll
            for (int m = 0; m < 4; ++m)
#pragma unroll
                for (int bj = 0; bj < 2; ++bj) { float fa[8], fb[8]; dec8(gav[m * 2 + bj], fa); dec8(gbv[m * 2 + bj], fb);
#pragma unroll
                    for (int q = 0; q < 4; ++q) { acc[ai][bj][m][0][q] *= fa[q] * fast_rcp(fmaxf(fb[q], 0.001953125f)); acc[ai][bj][m][1][q] *= fa[4 + q] * fast_rcp(fmaxf(fb[4 + q], 0.001953125f)); } }
        }
    }
    __device__ __forceinline__ void operator()(const f32x4 (&acc)[2][2][4][2], const Unit& u, int wr, int wc, int fr, int fq) const {
        if (nostore) return;
        const int row0 = u.pm * BM + wr * 64 + fr, col0 = u.pn * BM + wc * 32 + 8 * fq;
        int lo_ = ((wr * 4 + wc) * 64 + fq * 16 + fr) * 8; asm volatile("" : "+v"(lo_));
        const unsigned char* gb_p = G + ((size_t)(T / BM + u.pm) * 4 + u.pn) * (BM * BM) + (size_t)lo_;
        constexpr float SO = SM8 / SG8;
        u32x2 gbv[16];
#pragma unroll
        for (int i = 0; i < 16; ++i) gbv[i] = *(const u32x2*)(gb_p + i * 4096);
#pragma unroll
        for (int ai = 0; ai < 2; ++ai)
#pragma unroll
            for (int m = 0; m < 4; ++m) { const size_t row = (size_t)(row0 + ai * HALF + m * 16);
                unsigned char* rowp = O + row * D + col0;
#pragma unroll
                for (int bj = 0; bj < 2; ++bj) { const f32x4 v0 = acc[ai][bj][m][0], v1 = acc[ai][bj][m][1];
                    float fb[8]; dec8(gbv[(ai * 4 + m) * 2 + bj], fb);
                    float o[8];
#pragma unroll
                    for (int q = 0; q < 4; ++q) { o[q] = fmaxf(fb[q], 0.001953125f) * v0[q] * SO; o[4 + q] = fmaxf(fb[4 + q], 0.001953125f) * v1[q] * SO; }
                    u32x2 w; w.x = pk4_fp8(o[0], o[1], o[2], o[3]); w.y = pk4_fp8(o[4], o[5], o[6], o[7]);
                    *(u32x2*)(rowp + bj * HALF) = w; } asm volatile("" ::: "memory"); }
    }
};
struct EpiSwiglu {
    unsigned char* O;
    __device__ __forceinline__ void operator()(const f32x4 (&acc)[2][2][4][2], const Unit& u, int wr, int wc, int fr, int fq) const {
        const int row0 = u.pm * BM + wr * 64 + fr, col0 = u.pn * HALF + wc * 32 + 8 * fq;
#pragma unroll
        for (int ai = 0; ai < 2; ++ai)
#pragma unroll
            for (int m = 0; m < 4; ++m) { unsigned char* rowp = O + (size_t)(row0 + ai * HALF + m * 16) * DE + col0;
                float o[8];
#pragma unroll
                for (int n = 0; n < 2; ++n)
#pragma unroll
                    for (int q = 0; q < 4; ++q) { const float g = acc[ai][0][m][n][q], up = acc[ai][1][m][n][q]; o[4 * n + q] = g * fast_rcp(1.0f + fast_exp2(-LOG2E * g)) * up * SH8; }
                u32x2 w; w.x = pk4_fp8(o[0], o[1], o[2], o[3]); w.y = pk4_fp8(o[4], o[5], o[6], o[7]);
                *(u32x2*)rowp = w; asm volatile("" ::: "memory"); }
    }
};

struct SchedStatic {
    const char* A; const char* Bt; int nM, nN, G, c; size_t tstep;
    __device__ __forceinline__ bool next(int i, Unit& u) const { u.aux = 0; return static_tile(nM, nN, G, c, i, u.pm, u.pn); }
    __device__ __forceinline__ const char* abase(const Unit& u) const { return A + (size_t)u.pm * tstep; }
    __device__ __forceinline__ const char* bbase(const Unit& u) const { return Bt + (size_t)u.pn * tstep; }
};
struct SchedTwoSeg {
    const char* A0; long adiff; const char* B0; long bdiff; int nM, nN, G, c; size_t tile_bytes;
    __device__ __forceinline__ bool next(int i, Unit& u) const { u.aux = 0; return static_tile(nM, nN, G, c, i, u.pm, u.pn); }
    __device__ __forceinline__ const char* abase(const Unit& u) const { return A0 + (size_t)u.pm * tile_bytes; }
    __device__ __forceinline__ const char* bbase(const Unit& u) const { return B0 + (size_t)u.pn * tile_bytes; }
};
struct SchedMoe {
    const char* A; const char* Bt; const int* tok; const LAS int* t2e; const LAS int* tstart; const LAS int* cnt; int ntiles, G, vcu; size_t a_tile_bytes, b_exp_bytes, b_tile_bytes; int row_bytes;
    __device__ __forceinline__ bool next(int i, Unit& u) const { const int L = i * G + vcu; if (L >= 4 * ntiles) return false; u.pm = L >> 2; u.pn = L & 3; u.aux = t2e[u.pm]; return true; }
    __device__ __forceinline__ const char* abase(const Unit& u) const { return A + (size_t)u.pm * a_tile_bytes; }
    __device__ __forceinline__ const char* bbase(const Unit& u) const { return Bt + (size_t)u.aux * b_exp_bytes + (size_t)u.pn * b_tile_bytes; }
    __device__ __forceinline__ void gather(const Unit& u, const int (&R)[2], const int (&C)[2], unsigned (&voff)[2][2]) const {
        const int e = u.aux, lt = u.pm - tstart[e], nvalid = cnt[e] - lt * 256; const int* list = tok + (size_t)e * TOKCAP + lt * 256;
#pragma unroll
        for (int h = 0; h < 2; ++h)
#pragma unroll
            for (int i = 0; i < 2; ++i) { int r = h * HALF + R[i]; r = r < nvalid ? r : nvalid - 1; const int t = list[r]; voff[h][i] = (unsigned)(t * row_bytes + C[i] * 2); }
    }
    __device__ __forceinline__ void gather_issue(const Unit& u, const int (&R)[2], unsigned (&raw)[2][2]) const {
        const int e = u.aux, lt = u.pm - tstart[e], nvalid = cnt[e] - lt * 256; const int* list = tok + (size_t)e * TOKCAP + lt * 256;
#pragma unroll
        for (int h = 0; h < 2; ++h)
#pragma unroll
            for (int i = 0; i < 2; ++i) { int r = h * HALF + R[i]; r = r < nvalid ? r : nvalid - 1; asm volatile("global_load_dword %0, %1, off" : "=v"(raw[h][i]) : "v"(list + r) : "memory"); }
    }
    __device__ __forceinline__ unsigned gather_finish(unsigned raw, int c) const { asm volatile("" : "+v"(raw)); return (unsigned)((int)raw * row_bytes + c * 2); }
};
}

struct Frame {
    LAS unsigned char* lds;
    gu32* ctl;
    int tid, lane, wave, vcu, G, bid;
};

__device__ __forceinline__ void p0_transpose_item(const float* W, int K, int N, bf16_t* WT, int k0, int n0, int dst_row0, float sc, LAS float* scr, int lane) {
    const int q = lane & 7, ks = lane >> 3;
    f32x4 vv[8];
#pragma unroll
    for (int it = 0; it < 8; ++it) asm volatile("global_load_dwordx4 %0, %1, off nt" : "=v"(vv[it]) : "v"(W + (size_t)(k0 + it * 8 + ks) * N + n0 + 4 * q) : "memory");
    asm volatile("s_waitcnt vmcnt(0)" : "+v"(vv[0]), "+v"(vv[1]), "+v"(vv[2]), "+v"(vv[3]), "+v"(vv[4]), "+v"(vv[5]), "+v"(vv[6]), "+v"(vv[7]) :: "memory");
#pragma unroll
    for (int it = 0; it < 8; ++it) { const int kk = it * 8 + ks; const f32x4 v = vv[it];
        scr[kk * 33 + 4 * q + 0] = v[0]; scr[kk * 33 + 4 * q + 1] = v[1]; scr[kk * 33 + 4 * q + 2] = v[2]; scr[kk * 33 + 4 * q + 3] = v[3]; }
    asm volatile("s_waitcnt lgkmcnt(0)" ::: "memory");
    const int c = lane & 7;
#pragma unroll
    for (int j = 0; j < 4; ++j) { const int n = (lane >> 3) + 8 * j; const LAS float* s = scr + (8 * c) * 33 + n;
        u32x4 o; o.x = cvt_pk_bf16(s[0 * 33] * sc, s[1 * 33] * sc); o.y = cvt_pk_bf16(s[2 * 33] * sc, s[3 * 33] * sc); o.z = cvt_pk_bf16(s[4 * 33] * sc, s[5 * 33] * sc); o.w = cvt_pk_bf16(s[6 * 33] * sc, s[7 * 33] * sc);
        __builtin_nontemporal_store(o, (u32x4*)(WT + (size_t)(dst_row0 + n) * K + k0 + 8 * c)); }
    asm volatile("s_waitcnt lgkmcnt(0)" ::: "memory");
}

__device__ __forceinline__ void p0_transpose_item_f8(const float* W, int K, int N, unsigned char* WT, int k0, int n0, int dst_row0, float sc, LAS float* scr, int lane) {
    const int q = lane & 7, ks = lane >> 3;
    f32x4 vv[8];
#pragma unroll
    for (int it = 0; it < 8; ++it) asm volatile("global_load_dwordx4 %0, %1, off nt" : "=v"(vv[it]) : "v"(W + (size_t)(k0 + it * 8 + ks) * N + n0 + 4 * q) : "memory");
    asm volatile("s_waitcnt vmcnt(0)" : "+v"(vv[0]), "+v"(vv[1]), "+v"(vv[2]), "+v"(vv[3]), "+v"(vv[4]), "+v"(vv[5]), "+v"(vv[6]), "+v"(vv[7]) :: "memory");
#pragma unroll
    for (int it = 0; it < 8; ++it) { const int kk = it * 8 + ks; const f32x4 v = vv[it];
        scr[kk * 33 + 4 * q + 0] = v[0]; scr[kk * 33 + 4 * q + 1] = v[1]; scr[kk * 33 + 4 * q + 2] = v[2]; scr[kk * 33 + 4 * q + 3] = v[3]; }
    asm volatile("s_waitcnt lgkmcnt(0)" ::: "memory");
    const int c = lane & 7;
#pragma unroll
    for (int j = 0; j < 4; ++j) { const int n = (lane >> 3) + 8 * j; const LAS float* s = scr + (8 * c) * 33 + n;
        u32x2 o; o.x = pk4_fp8(s[0 * 33] * sc, s[1 * 33] * sc, s[2 * 33] * sc, s[3 * 33] * sc); o.y = pk4_fp8(s[4 * 33] * sc, s[5 * 33] * sc, s[6 * 33] * sc, s[7 * 33] * sc);
        __builtin_nontemporal_store(o, (u32x2*)(WT + (size_t)(dst_row0 + n) * K + k0 + 8 * c)); }
    asm volatile("s_waitcnt lgkmcnt(0)" ::: "memory");
}

struct Args { const float* in[16]; float* out; unsigned char* ws; int ph_lo, ph_hi; };

constexpr int N_PHASES = 1 + 8 * DEPTH;


typedef const __attribute__((address_space(4))) Args* kargp_t;
extern __shared__ __attribute__((aligned(16))) unsigned char lds_raw[];
#define PHASE_ENTRY() Frame F; F.lds = (LAS unsigned char*)lds_raw; F.wave = wv; F.lane = lane_now(); F.tid = wv * 64 + F.lane; \
    F.G = gridDim.x; { int bx = blockIdx.x; asm volatile("" : "+s"(bx)); F.bid = bx; F.vcu = (F.G % 8 == 0) ? (bx % 8) * (F.G / 8) + bx / 8 : bx; } \
    kargp_t kp = (kargp_t)__builtin_amdgcn_kernarg_segment_ptr(); asm volatile("" : "+s"(kp)); unsigned char* ws = kp->ws; F.ctl = (gu32*)(ws + WS_CTL);
#define x_in (kp->in[0])
#define w_in (kp->in[1])
#define b_in (kp->in[2])
#define sinks (kp->in[3])
#define w_bra (kp->in[4])
#define w_brb (kp->in[5])
#define w_out (kp->in[6])
#define ln1_g (kp->in[7])
#define ln1_b (kp->in[8])
#define w_router (kp->in[9])
#define router_bias (kp->in[10])
#define w_gate (kp->in[11])
#define w_up (kp->in[12])
#define w_down (kp->in[13])
#define ln2_g (kp->in[14])
#define ln2_b (kp->in[15])
#define xres (kp->out)
#define bias_s ((float*)(ws + WS_BIAS))
#define Win_t ((bf16_t*)(ws + WS_WIN))
#define Wa_t ((bf16_t*)(ws + WS_WA))
#define Wb_t ((bf16_t*)(ws + WS_WB))
#define Wo_t ((bf16_t*)(ws + WS_WO))
#define Wgu_t ((bf16_t*)(ws + WS_WGU))
#define Wd_t ((bf16_t*)(ws + WS_WD))
#define xb ((bf16_t*)(ws + WS_XB))
#define proj ((bf16_t*)(ws + WS_PROJ))
#define hbuf ((bf16_t*)(ws + WS_H))
#define y2 ((bf16_t*)(ws + WS_Y2))
#define ya ((bf16_t*)(ws + WS_YA))
#define yb ((bf16_t*)(ws + WS_YB))
#define mix ((unsigned char*)(ws + WS_MIX))
#define merged ((bf16_t*)(ws + WS_MERGED))
#define tok ((int*)(ws + WS_TOK))
#define slot_e ((int*)(ws + WS_SLOT))
#define slot_r (slot_e + T * 2)
#define slot_g ((float*)(slot_r + T * 2))


namespace att {
typedef float f32x16 __attribute__((ext_vector_type(16)));
typedef short s16x4 __attribute__((ext_vector_type(4)));
typedef short v4i16_t __attribute__((ext_vector_type(4)));
constexpr int SLOTB = 8192, NSLOT = 6;
constexpr int LDS_K = 0, LDS_V = NSLOT * SLOTB, LDS_OST = 2 * NSLOT * SLOTB;
static_assert(LDS_OST + 8 * 4096 <= RING_BYTES, "attention LDS map");
__device__ __forceinline__ int crow(int r, int hi) { return (r & 3) + 8 * (r >> 2) + 4 * hi; }
__device__ __forceinline__ void glds16(const void* gsrc, unsigned lds_dst) { unsigned keep;
    asm volatile("s_mov_b32 %0, m0\n\ts_mov_b32 m0, %2\n\ts_nop 0\n\tglobal_load_lds_dwordx4 %1, off\n\ts_mov_b32 m0, %0" : "=&s"(keep) : "v"(gsrc), "s"(lds_dst) : "memory"); }
typedef const LAS char* lds_cptr;
__device__ __forceinline__ void kload8(bf16x8* kf, lds_cptr kp) {
    kf[0] = *(const LAS bf16x8*)(kp);        kf[1] = *(const LAS bf16x8*)(kp + 512);
    kf[2] = *(const LAS bf16x8*)(kp + 2048); kf[3] = *(const LAS bf16x8*)(kp + 2560);
    kf[4] = *(const LAS bf16x8*)(kp + 4096); kf[5] = *(const LAS bf16x8*)(kp + 4608);
    kf[6] = *(const LAS bf16x8*)(kp + 6144); kf[7] = *(const LAS bf16x8*)(kp + 6656);
}
__device__ __forceinline__ s16x4 vtr(lds_cptr p) { return __builtin_bit_cast(s16x4, __builtin_amdgcn_ds_read_tr16_b64_v4i16((LAS v4i16_t*)p)); }
__device__ __forceinline__ void qkt(f32x16& p0, f32x16& p1, const bf16x8* kf, const bf16x8* qr) {
    p0 = (f32x16){}; p1 = (f32x16){};
#pragma unroll
    for (int d0 = 0; d0 < 4; ++d0) { p0 = __builtin_amdgcn_mfma_f32_32x32x16_bf16(kf[2 * d0], qr[d0], p0, 0, 0, 0); p1 = __builtin_amdgcn_mfma_f32_32x32x16_bf16(kf[2 * d0 + 1], qr[d0], p1, 0, 0, 0); }
}
__device__ __forceinline__ void pv_ks(f32x16* o, lds_cptr vp, int ks, bf16x8 pa) {
#pragma unroll
    for (int d0 = 0; d0 < 2; ++d0) {
        const s16x4 lo = vtr(vp + d0 * 4096 + ks * 1024), hi = vtr(vp + d0 * 4096 + ks * 1024 + 512);
        const bf16x8 vf = (bf16x8){lo[0], lo[1], lo[2], lo[3], hi[0], hi[1], hi[2], hi[3]};
        o[d0] = __builtin_amdgcn_mfma_f32_32x32x16_bf16(pa, vf, o[d0], 0, 0, 0);
    }
}
__device__ __forceinline__ bf16x8 pack8(const f32x16& p, int b) {
    u32x4 w; w.x = cvt_pk_bf16(p[b], p[b + 1]); w.y = cvt_pk_bf16(p[b + 2], p[b + 3]); w.z = cvt_pk_bf16(p[b + 4], p[b + 5]); w.w = cvt_pk_bf16(p[b + 6], p[b + 7]);
    return __builtin_bit_cast(bf16x8, w);
}
__device__ __forceinline__ void store_o(const f32x16* o, LAS char* stage, unsigned char* dst, int ldo, int lane) {
    const int r32 = lane & 31, hi = lane >> 5;
    LAS unsigned char* stg = (LAS unsigned char*)stage;
#pragma unroll
    for (int r = 0; r < 16; ++r) { const int orow = crow(r, hi);
        const unsigned w = (unsigned)__builtin_amdgcn_cvt_pk_fp8_f32(o[0][r] * SY8, o[1][r] * SY8, 0, false);
        stg[orow * 64 + r32] = (unsigned char)(w & 0xffu); stg[orow * 64 + 32 + r32] = (unsigned char)((w >> 8) & 0xffu); }
    asm volatile("s_waitcnt lgkmcnt(0)" ::: "memory");
#pragma unroll
    for (int i = 0; i < 2; ++i) { const int piece = i * 64 + lane, row = piece >> 2, ch = piece & 3; const u32x4 v = *(const LAS u32x4*)(stg + row * 64 + ch * 16); *(u32x4*)(dst + (size_t)row * ldo + ch * 16) = v; }
    asm volatile("s_waitcnt lgkmcnt(0)" ::: "memory");
}
#define ATT_WAIT_BAR(N) asm volatile("s_waitcnt vmcnt(" #N ") lgkmcnt(0)\n\ts_barrier" ::: "memory")

__device__ __forceinline__ void sb_unit(int b, int hp, int qb, const bf16_t* pj, unsigned char* yout, LAS char* lds, LAS int* flags, int tid) {
    const int lane = tid & 63, r32 = lane & 31, hi = lane >> 5; const int wid = __builtin_amdgcn_readfirstlane(tid >> 6);
    const int grp = wid >> 2, lw = wid & 3, h = 2 * hp + grp;
    const size_t rowbase = (size_t)b * SEQ; const int q0 = qb * 128;
    const bf16_t* Qw = pj + (rowbase + q0 + lw * 32) * PP + C_SQ + h * 64;
    const bf16_t* Kh = pj + rowbase * PP + C_SK + h * 64; const bf16_t* Vh = pj + rowbase * PP + C_SV + h * 64;
    const unsigned lds0 = (unsigned)(uintptr_t)lds;
    const bf16_t* ksrc = Kh + (size_t)lane * PP + (2 * lw) * 8;
    const bf16_t* vsrc0 = Vh + (size_t)(16 * ((2 * lw) & 3) + (lane >> 2)) * PP + ((2 * lw) >> 2) * 32 + (lane & 3) * 8;
    const bf16_t* vsrc1 = Vh + (size_t)(16 * ((2 * lw + 1) & 3) + (lane >> 2)) * PP + ((2 * lw + 1) >> 2) * 32 + (lane & 3) * 8;
    const unsigned kdst = lds0 + LDS_K + grp * 3 * SLOTB + (2 * lw) * 1024, vdst = lds0 + LDS_V + grp * 3 * SLOTB + (2 * lw) * 1024;
#define SB_DMA(t, slot) do { const size_t to_ = (size_t)(t) * 64 * PP; \
        glds16(ksrc + to_, (unsigned)__builtin_amdgcn_readfirstlane(kdst + (slot))); glds16(ksrc + to_ + 8, (unsigned)__builtin_amdgcn_readfirstlane(kdst + (slot) + 1024)); \
        glds16(vsrc0 + to_, (unsigned)__builtin_amdgcn_readfirstlane(vdst + (slot))); glds16(vsrc1 + to_, (unsigned)__builtin_amdgcn_readfirstlane(vdst + (slot) + 1024)); } while (0)
    const lds_cptr kp0 = (lds_cptr)lds + LDS_K + grp * 3 * SLOTB + hi * 1024 + r32 * 16;
    const lds_cptr vp0 = (lds_cptr)lds + LDS_V + grp * 3 * SLOTB + ((lane >> 4) & 1) * 32 + (lane & 3) * 8 + (4 * hi + ((lane & 15) >> 2)) * 64;
    const int jhi = 2 * qb + 1, jw = 2 * qb + (lw >> 1);
    bf16x8 qr[4];
#pragma unroll
    for (int d0 = 0; d0 < 4; ++d0) qr[d0] = *(const bf16x8*)(Qw + (size_t)r32 * PP + d0 * 16 + hi * 8);
    SB_DMA(jhi, 0); SB_DMA(jhi - 1, SLOTB);
    asm volatile("s_waitcnt vmcnt(8)" : "+v"(qr[0]), "+v"(qr[1]), "+v"(qr[2]), "+v"(qr[3]) :: "memory");
    if (tid < 16) flags[tid] = 0;
    f32x16 o[2]; o[0] = (f32x16){}; o[1] = (f32x16){};
    float carry = 1.0f; bool done = false;
    const int trow = 32 * (lw & 1) + r32;
    const int lag = (lw < 2) ? 1 : 0;
    int sl_m = lag ? SLOTB : 0;
    int sl_cur = 0, sl_n2 = 2 * SLOTB;
    for (int n = 0;; ++n) {
        const int j = jhi - n; if (j < 0) break;
        ATT_WAIT_BAR(0);
        if (n > 0) { const LAS int* f = flags + ((n - 1) & 1) * 8; const int all = f[0] & f[1] & f[2] & f[3] & f[4] & f[5] & f[6] & f[7]; if (__builtin_amdgcn_readfirstlane(all)) break; }
        if (j >= 2) SB_DMA(j - 2, sl_n2);
        const int jm = j - lag;
        const bool active = (jm >= 0) && !done;
        if (active) {
            const bool diag = (jm == jw);
            const bool skip1 = diag && !(lw & 1);
            bf16x8 kf[8]; kload8(kf, kp0 + sl_m);
            f32x16 p0 = (f32x16){}, p1 = (f32x16){};
#pragma unroll
            for (int d0 = 0; d0 < 4; ++d0) p0 = __builtin_amdgcn_mfma_f32_32x32x16_bf16(kf[2 * d0], qr[d0], p0, 0, 0, 0);
            if (!skip1) {
#pragma unroll
                for (int d0 = 0; d0 < 4; ++d0) p1 = __builtin_amdgcn_mfma_f32_32x32x16_bf16(kf[2 * d0 + 1], qr[d0], p1, 0, 0, 0);
            }
            const int lim = diag ? trow : 4096;
            const lds_cptr vp = vp0 + sl_m;
#pragma unroll
            for (int blk = 1; blk >= 0; --blk) {
                if (blk == 1 && skip1) continue;
                f32x16& p = blk ? p1 : p0;
                float G[4];
#pragma unroll
                for (int g = 0; g < 4; ++g) {
#pragma unroll
                    for (int i = 0; i < 4; ++i) { const int r = 4 * g + i;
                        const float e = fast_exp2(p[r]); const float rr = fast_rcp(1.0f + e);
                        p[r] = rr; }
                    if (diag) {
#pragma unroll
                        for (int i = 0; i < 4; ++i) { const int r = 4 * g + i; p[r] = ((32 * blk + crow(r, hi)) < lim) ? p[r] : 1.0f; } }
                    G[g] = (p[4 * g] * p[4 * g + 1]) * (p[4 * g + 2] * p[4 * g + 3]);
                }
                float Tg[4], Gh[4]; float run = carry;
#pragma unroll
                for (int g = 3; g >= 0; --g) { const unsigned gu = __float_as_uint(G[g]); auto rrp = __builtin_amdgcn_permlane32_swap(gu, gu, false, false);
                    const float glo = __uint_as_float(rrp[0]), ghi = __uint_as_float(rrp[1]); Tg[g] = run; Gh[g] = ghi; run = run * (glo * ghi); }
                carry = run;
#pragma unroll
                for (int g = 0; g < 4; ++g) { float x = hi ? Tg[g] : Tg[g] * Gh[g];
                    const float k0 = p[4 * g], k1 = p[4 * g + 1], k2 = p[4 * g + 2], k3 = p[4 * g + 3];
                    float xn = x * k3; p[4 * g + 3] = x - xn; x = xn; xn = x * k2; p[4 * g + 2] = x - xn; x = xn; xn = x * k1; p[4 * g + 1] = x - xn; x = xn; p[4 * g] = x - x * k0; }
                pv_ks(o, vp, 2 * blk, pack8(p, 0)); pv_ks(o, vp, 2 * blk + 1, pack8(p, 8));
            }
            done = __all(carry < 1e-37f) || (jm == 0);
        }
        if (lane == 0) flags[(n & 1) * 8 + wid] = (done || (jm <= 0)) ? 1 : 0;
        { const int t_ = sl_cur; sl_cur = (sl_cur == 2 * SLOTB) ? 0 : sl_cur + SLOTB; sl_n2 = t_; sl_m = (sl_m == 2 * SLOTB) ? 0 : sl_m + SLOTB; }
    }
    asm volatile("s_waitcnt vmcnt(0)" ::: "memory");
    store_o(o, lds + LDS_OST + wid * 4096, yout + (rowbase + q0 + lw * 32) * 512 + h * 64, 512, lane);
    asm volatile("s_waitcnt lgkmcnt(0)\n\ts_barrier" ::: "memory");
#undef SB_DMA
}

__device__ __forceinline__ void swa_dma(const bf16_t* pj, int u, unsigned lds0, int set, int lane, int wid) {
    const int a = u & 31, kvh = (u >> 5) & 1, b = u >> 6;
    const bf16_t* Kh = pj + (size_t)b * SEQ * PP + C_AK + kvh * 64; const bf16_t* Vh = pj + (size_t)b * SEQ * PP + C_AV + kvh * 64;
#pragma unroll
    for (int i = 0; i < 3; ++i) { int jt = a - 2 + i; jt = jt < 0 ? 0 : jt;
        glds16(Kh + ((size_t)jt * 64 + lane) * PP + wid * 8, (unsigned)__builtin_amdgcn_readfirstlane(lds0 + LDS_K + (set * 3 + i) * SLOTB + wid * 1024));
        glds16(Vh + ((size_t)jt * 64 + 16 * (wid & 3) + (lane >> 2)) * PP + (wid >> 2) * 32 + (lane & 3) * 8, (unsigned)__builtin_amdgcn_readfirstlane(lds0 + LDS_V + (set * 3 + i) * SLOTB + wid * 1024)); }
}
__device__ __forceinline__ void swa_q(bf16x8* qr, const bf16_t* pj, int u, int lane, int wid) {
    const int a = u & 31, kvh = (u >> 5) & 1, b = u >> 6, g = wid >> 1, half = wid & 1, qh = kvh * 4 + g, r32 = lane & 31, hi = lane >> 5;
    const size_t row0 = (size_t)b * SEQ + a * 64 + half * 32;
#pragma unroll
    for (int d0 = 0; d0 < 4; ++d0) qr[d0] = *(const bf16x8*)(pj + (row0 + r32) * PP + C_AQ + qh * 64 + d0 * 16 + hi * 8);
}
__device__ __forceinline__ void swa_unit(int u, int set, const bf16x8* qr, unsigned char* yout, const float* sinks_l, LAS char* lds, int tid) {
    const int lane = tid & 63, r32 = lane & 31, hi = lane >> 5; const int wid = __builtin_amdgcn_readfirstlane(tid >> 6);
    const int a = u & 31, kvh = (u >> 5) & 1, b = u >> 6, g = wid >> 1, half = wid & 1, qh = kvh * 4 + g;
    const size_t row0 = (size_t)b * SEQ + a * 64 + half * 32;
    unsigned sk_; { const float* sp_ = sinks_l + qh; asm volatile("s_load_dword %0, %1, 0x0\n\ts_waitcnt lgkmcnt(0)" : "=s"(sk_) : "s"(sp_) : "memory"); }
    const float slope2 = LOG2E * exp2f(-(float)(qh + 1)), sink2 = __uint_as_float(sk_) * LOG2E;
    const lds_cptr kp0 = (lds_cptr)lds + LDS_K + set * 3 * SLOTB + hi * 1024 + r32 * 16;
    const lds_cptr vp0 = (lds_cptr)lds + LDS_V + set * 3 * SLOTB + ((lane >> 4) & 1) * 32 + (lane & 3) * 8 + (4 * hi + ((lane & 15) >> 2)) * 64;
    f32x16 s[3][2];
#pragma unroll
    for (int i = 0; i < 3; ++i) { bf16x8 kf[8]; kload8(kf, kp0 + i * SLOTB);
        s[i][0] = (f32x16){}; s[i][1] = (f32x16){};
        if (!(i == 0 && half == 1)) {
#pragma unroll
            for (int d0 = 0; d0 < 4; ++d0) s[i][0] = __builtin_amdgcn_mfma_f32_32x32x16_bf16(kf[2 * d0], qr[d0], s[i][0], 0, 0, 0); }
        if (!(i == 2 && half == 0)) {
#pragma unroll
            for (int d0 = 0; d0 < 4; ++d0) s[i][1] = __builtin_amdgcn_mfma_f32_32x32x16_bf16(kf[2 * d0 + 1], qr[d0], s[i][1], 0, 0, 0); } }
    float m = sink2;
#pragma unroll
    for (int i = 0; i < 3; ++i) { const bool tile_ok = (a - 2 + i) >= 0;
#pragma unroll
        for (int blk = 0; blk < 2; ++blk) { const int dbase = 64 * (2 - i) + 32 * half + r32 - 32 * blk;
#pragma unroll
            for (int r = 0; r < 16; ++r) { const int dist = dbase - crow(r, hi); const bool valid = tile_ok && dist >= 0 && dist < 128;
                const float v = s[i][blk][r] - slope2 * (float)dist; s[i][blk][r] = valid ? v : -INFINITY; m = fmaxf(m, s[i][blk][r]); } } }
    { const unsigned mu = __float_as_uint(m); auto rr = __builtin_amdgcn_permlane32_swap(mu, mu, false, false); m = fmaxf(__uint_as_float(rr[0]), __uint_as_float(rr[1])); }
    float lsum = 0.f;
#pragma unroll
    for (int i = 0; i < 3; ++i)
#pragma unroll
        for (int blk = 0; blk < 2; ++blk)
#pragma unroll
            for (int r = 0; r < 16; ++r) { const float pe = fast_exp2(s[i][blk][r] - m); s[i][blk][r] = pe; lsum += pe; }
    { const unsigned lu = __float_as_uint(lsum); auto rr = __builtin_amdgcn_permlane32_swap(lu, lu, false, false); lsum = __uint_as_float(rr[0]) + __uint_as_float(rr[1]); }
    const float inv = 1.0f / (lsum + fast_exp2(sink2 - m));
    f32x16 o[2]; o[0] = (f32x16){}; o[1] = (f32x16){};
#pragma unroll
    for (int i = 0; i < 3; ++i)
#pragma unroll
        for (int blk = 0; blk < 2; ++blk) {
            if ((i == 0 && blk == 0 && half == 1) || (i == 2 && blk == 1 && half == 0)) continue;
#pragma unroll
            for (int r = 0; r < 16; ++r) s[i][blk][r] *= inv;
            pv_ks(o, vp0 + i * SLOTB, 2 * blk, pack8(s[i][blk], 0)); pv_ks(o, vp0 + i * SLOTB, 2 * blk + 1, pack8(s[i][blk], 8)); }
    store_o(o, lds + LDS_OST + wid * 4096, yout + row0 * 512 + qh * 64, 512, lane);
}
}

__device__ __forceinline__ void phase_attn_mfma(int l, const int wv) {
    PHASE_ENTRY();
    LAS char* lds = (LAS char*)F.lds; LAS int* flags = (LAS int*)(F.lds + LC_HIST);
    const bool xmap = (F.G == 256); const int u_first = xmap ? (F.vcu >> 5) * 128 + (F.vcu & 31) : F.bid, u_step = xmap ? 32 : F.G;
    const int sb_end = xmap ? (F.vcu >> 5) * 128 + 128 : BATCH * 4 * 16, swa_end = xmap ? (F.vcu >> 5) * 128 + 128 : BATCH * 2 * 32;
    for (int rep_ = 0; rep_ < NREP(9); ++rep_)
    for (int u = u_first; u < sb_end; u += u_step) { const int qb = ((u & 15) + (xmap ? ((u >> 5) & 3) : (u >> 8)) * 5) & 15;
        att::sb_unit(u >> 6, (u >> 4) & 3, qb, proj, (unsigned char*)(ws + WS_YA + 16 * MiB), lds, flags, F.tid); }
    for (int rep_ = 0; rep_ < NREP(10); ++rep_) {
    const unsigned lds0 = (unsigned)(uintptr_t)lds; int set = 0;
    bf16x8 qc[4], qn[4];
#pragma unroll
    for (int d0 = 0; d0 < 4; ++d0) { qc[d0] = (bf16x8){}; qn[d0] = (bf16x8){}; }
    if (u_first < swa_end) { att::swa_q(qc, proj, u_first, F.lane, F.wave); att::swa_dma(proj, u_first, lds0, 0, F.lane, F.wave); }
    for (int u = u_first; u < swa_end; u += u_step) {
        ATT_WAIT_BAR(0);
        const bool more = (u + u_step < swa_end);
        if (more) { att::swa_q(qn, proj, u + u_step, F.lane, F.wave); att::swa_dma(proj, u + u_step, lds0, set ^ 1, F.lane, F.wave); }
        att::swa_unit(u, set, qc, (unsigned char*)(ws + WS_YA), sinks + l * 8, lds, F.tid);
        if (more) {
#pragma unroll
            for (int d0 = 0; d0 < 4; ++d0) qc[d0] = qn[d0]; }
        set ^= 1;
    }
    asm volatile("s_waitcnt vmcnt(0) lgkmcnt(0)\n\ts_barrier" ::: "memory");
    }
}


__device__ __forceinline__ int moe_tables(Frame& F, int l) {
    LAS int* cnt = (LAS int*)(F.lds + LC_CNT); LAS int* tstart = (LAS int*)(F.lds + LC_TSTART); LAS int* t2e = (LAS int*)(F.lds + LC_T2E);
    __syncthreads();
    if (F.wave == 0) {
        const int c = (F.lane < NE) ? (int)__hip_atomic_load(F.ctl + CW_CNT + 64 * l + F.lane, __ATOMIC_RELAXED, __HIP_MEMORY_SCOPE_AGENT) : 0;
        const int n = (c + 255) >> 8; int st = 0, tot = 0;
#pragma unroll
        for (int j = 0; j < NE; ++j) { const int nj = __builtin_amdgcn_readlane(n, j); st += (j < F.lane) ? nj : 0; tot += nj; }
        if (F.lane < NE) { cnt[F.lane] = c; tstart[F.lane] = st; for (int j = 0; j < n; ++j) t2e[st + j] = F.lane; }
        if (F.lane == 0) tstart[NE] = tot;
    }
    __syncthreads();
    return tstart[NE];
}
__device__ __forceinline__ int moe_tables_cached(Frame& F, int l) {
#if MK_ONE_LAUNCH
    (void)l; return ((const LAS int*)(F.lds + LC_TSTART))[NE];
#else
    return moe_tables(F, l);
#endif
}


constexpr int CI_IN = (D / 64) * (NIN / 32), CI_BR = (512 / 64) * (D / 32), CI_WO = (D / 64) * (D / 32), CI_GU = NE * (D / 64) * (DE / 32), CI_DN = NE * (DE / 64) * (D / 32);
constexpr int NPL = CI_IN + 2 * CI_BR + CI_WO + 2 * CI_GU + CI_DN;
__device__ __forceinline__ void convert_item(kargp_t kp, unsigned char* ws, int l, int r, LAS float* scr, int lane) {
    const float* W; unsigned char* WT; int K, N, k0, n0, drow; float sc = 1.0f; bool f8 = true;
    if (r < CI_IN) { const int kb = r / (NIN / 32), nb = r % (NIN / 32); n0 = nb * 32; k0 = kb * 64; drow = n0; K = D; N = NIN;
        sc = (((n0 < C_AK) || (n0 >= C_SQ && n0 < C_SK)) ? C2 : 1.0f) * SW8; W = w_in + (size_t)l * D * NIN; WT = (unsigned char*)(ws + WS_WIN) + (size_t)l * NIN * D; }
    else if ((r -= CI_IN) < 2 * CI_BR) { const int bb = r >= CI_BR; if (bb) r -= CI_BR; const int kb = r / (D / 32), nb = r % (D / 32); n0 = nb * 32; k0 = kb * 64; drow = n0; K = 512; N = D; sc = SW8;
        W = (bb ? w_brb : w_bra) + (size_t)l * 512 * D; WT = (unsigned char*)(ws + (bb ? WS_WB : WS_WA)) + (size_t)l * D * 512; }
    else if ((r -= 2 * CI_BR) < CI_WO) { const int kb = r / (D / 32), nb = r % (D / 32); n0 = nb * 32; k0 = kb * 64; drow = n0; K = D; N = D; sc = SW8;
        W = w_out + (size_t)l * D * D; WT = (unsigned char*)(ws + WS_WO) + (size_t)l * D * D; }
    else if ((r -= CI_WO) < 2 * CI_GU) { sc = SW8; const int up = r >= CI_GU; if (up) r -= CI_GU; constexpr int per = (D / 64) * (DE / 32); const int le = l * NE + r / per, q = r % per, kb = q / (DE / 32), nb = q % (DE / 32);
        n0 = nb * 32; k0 = kb * 64; drow = (n0 >> 7) * 256 + (n0 & 127) + (up ? 128 : 0); K = D; N = DE;
        W = (up ? w_up : w_gate) + (size_t)le * D * DE; WT = (unsigned char*)(ws + WS_WGU) + (size_t)le * 1024 * D; }
    else { r -= 2 * CI_GU; constexpr int per = (DE / 64) * (D / 32); const int le = l * NE + r / per, q = r % per, kb = q / (D / 32), nb = q % (D / 32); n0 = nb * 32; k0 = kb * 64; drow = n0; K = DE; N = D; sc = SW8;
        W = w_down + (size_t)le * DE * D; WT = (unsigned char*)(ws + WS_WD) + (size_t)le * D * DE; }
    if (f8) p0_transpose_item_f8(W, K, N, WT, k0, n0, drow, sc, scr, lane);
    else p0_transpose_item(W, K, N, (bf16_t*)WT, k0, n0, drow, sc, scr, lane);
}
constexpr int CW_CQ = 12288;
constexpr int QB = 32, QTOTAL = (DEPTH - 1) * NPL;
static_assert(QTOTAL % QB == 0, "queue batches");
constexpr int LW_REL = 12, LW_Q = 13, LW_GEN = 14, LW_QDONE = 15;
__device__ __forceinline__ int cq_take(unsigned char* ws, int lane, int claim_limit) {
    volatile LAS int* misc = (volatile LAS int*)((LAS unsigned char*)lds_raw + LC_MISC);
    gu32* cq = (gu32*)(ws + WS_CTL) + CW_CQ;
    for (int tries = 0; tries < (1 << 20); ++tries) {
        if (misc[LW_QDONE]) return -1;
        int old = 0;
        if (lane == 0) old = __hip_atomic_fetch_add((LAS int*)((LAS unsigned char*)lds_raw + LC_MISC) + LW_Q, 1, __ATOMIC_RELAXED, __HIP_MEMORY_SCOPE_WORKGROUP);
        old = __builtin_amdgcn_readfirstlane(old);
        const int i = old & 255, batch = (int)((unsigned)old >> 8);
        if (i < QB) return batch * QB + i;
        if (i == QB) {
            int nb = -1;
            if (lane == 0) { const int p = (int)__hip_atomic_load(cq, __ATOMIC_RELAXED, __HIP_MEMORY_SCOPE_AGENT); if (p * QB < claim_limit) nb = (int)__hip_atomic_fetch_add(cq, 1u, __ATOMIC_RELAXED, __HIP_MEMORY_SCOPE_AGENT); }
            nb = __builtin_amdgcn_readfirstlane(nb);
            if (nb < 0) { if (lane == 0) misc[LW_Q] = (batch << 8) | QB; return -1; }
            if (nb * QB >= QTOTAL) { if (lane == 0) { misc[LW_QDONE] = 1; misc[LW_Q] = (batch << 8) | QB; } return -1; }
            if (lane == 0) misc[LW_Q] = (nb << 8) | 1;
            return nb * QB;
        }
        while ((misc[LW_Q] & 255) > QB && !misc[LW_QDONE]) __builtin_amdgcn_s_sleep(2);
    }
    return -1;
}
__device__ __forceinline__ bool cq_step(kargp_t kp, unsigned char* ws, LAS float* scr, int lane, int claim_limit) {
    const int k = cq_take(ws, lane, claim_limit);
    if (k < 0) return false;
    convert_item(kp, ws, 1 + k / NPL, k % NPL, scr, lane);
    return true;
}

__device__ __forceinline__ void phase_prologue(const int wv) {
    PHASE_ENTRY();
    LAS float* scr = (LAS float*)(F.lds + F.wave * 16384);
    const int gw = F.vcu * NWAVES + F.wave, NGW = F.G * NWAVES;
#if MK_ONE_LAUNCH
    constexpr int NL0 = 1;
#else
    constexpr int NL0 = DEPTH;
#endif
    for (int it = gw; it < NL0 * NPL; it += NGW) convert_item(kp, ws, it / NPL, it % NPL, scr, F.lane);
    { const size_t NV = (size_t)T * D / 4, st = (size_t)F.G * NTHREADS;
      for (size_t i0 = (size_t)F.bid * NTHREADS + F.tid; i0 < NV; i0 += 8 * st) {
        f32x4 v[8];
#pragma unroll
        for (int k = 0; k < 8; ++k) { const size_t i = i0 + k * st; v[k] = (i < NV) ? __builtin_nontemporal_load((const f32x4*)x_in + i) : (f32x4){}; }
#pragma unroll
        for (int k = 0; k < 8; ++k) { const size_t i = i0 + k * st; if (i < NV) { u32x2 o; o.x = cvt_pk_bf16(v[k][0], v[k][1]); o.y = cvt_pk_bf16(v[k][2], v[k][3]); ((u32x2*)xb)[i] = o;
            ((unsigned*)(ws + WS_XF8))[i] = pk4_fp8(v[k][0] * SX8, v[k][1] * SX8, v[k][2] * SX8, v[k][3] * SX8); } }
      } }
    for (int i = F.bid * NTHREADS + F.tid; i < DEPTH * NIN; i += F.G * NTHREADS) { const int n = i % NIN; bias_s[i] = b_in[i] * (((n < C_AK) || (n >= C_SQ && n < C_SK)) ? C2 : 1.0f); }
}

__device__ __forceinline__ void phase_ln1(int l, const bool dummy, const int wv) {
    PHASE_ENTRY();
    bf16_t* xdst = dummy ? merged : xb;
    LAS unsigned char* Tb = F.lds;
    LAS float* red = (LAS float*)F.lds;
    LAS float* Lg = (LAS float*)(F.lds + LC_LOGIT);
    LAS int* hist = (LAS int*)(F.lds + LC_HIST); LAS int* basev = (LAS int*)(F.lds + LC_BASE);
    LAS int* se = (LAS int*)(F.lds + LC_SE); LAS int* sr = (LAS int*)(F.lds + LC_SR); LAS float* sg = (LAS float*)(F.lds + LC_SG);
    const int hh = F.lane >> 5, jx = F.lane & 31;
    { LAS float* gb = (LAS float*)(F.lds + LC_GB);
      *(LAS f32x2*)(gb + 2 * F.tid) = *(const f32x2*)(ln1_g + l * D + 2 * F.tid); *(LAS f32x2*)(gb + D + 2 * F.tid) = *(const f32x2*)(ln1_b + l * D + 2 * F.tid);
      if (F.tid < NE) ((LAS float*)(F.lds + LC_RB))[F.tid] = router_bias[F.tid]; }
    bf16x8 bwh[8], bwl[8];
    float wraw[64];
#pragma unroll
    for (int s = 0; s < 64; ++s) wraw[s] = w_router[(size_t)(128 * F.wave + 16 * (s >> 3) + 8 * hh + (s & 7)) * NE + jx];
#pragma unroll
    for (int s = 0; s < 8; ++s)
#pragma unroll
        for (int i = 0; i < 8; i += 2) { const float w0 = wraw[8 * s + i], w1 = wraw[8 * s + i + 1];
            const unsigned h = cvt_pk_bf16(w0, w1); const unsigned lo = cvt_pk_bf16(w0 - bf_lo(h), w1 - bf_hi(h));
            bwh[s][i] = (short)(h & 0xffffu); bwh[s][i + 1] = (short)(h >> 16); bwl[s][i] = (short)(lo & 0xffffu); bwl[s][i + 1] = (short)(lo >> 16); }
    for (int rb = (F.G == 256) ? F.vcu : F.bid; rb < T / 128; rb += F.G) {
        if (F.tid < NE) hist[F.tid] = 0;
        __syncthreads();
        u32x2 xr[4][4]; unsigned mr[4][4];
#define LN1_LOAD_ROUND(rnd) do { _Pragma("unroll") for (int q_ = 0; q_ < 4; ++q_) { const size_t row_ = (size_t)rb * 128 + (rnd) * 32 + 4 * F.wave + q_; \
            _Pragma("unroll") for (int j_ = 0; j_ < 4; ++j_) { xr[q_][j_] = *(const u32x2*)(xb + row_ * D + 256 * j_ + 4 * F.lane); mr[q_][j_] = *(const unsigned*)((const unsigned char*)mix + row_ * D + 256 * j_ + 4 * F.lane); } } } while (0)
        LN1_LOAD_ROUND(0);
        for (int round = 0; round < 4; ++round) {
#pragma unroll
            for (int qp = 0; qp < 4; qp += 2) {
                f32x4 v[2][4]; float s[2], s2[2];
#pragma unroll
                for (int q = 0; q < 2; ++q) { s[q] = 0.f;
#pragma unroll
                    for (int j = 0; j < 4; ++j) { const u32x2 xv = xr[qp + q][j]; const f32x2 m01 = __builtin_amdgcn_cvt_pk_f32_fp8((int)mr[qp + q][j], false), m23 = __builtin_amdgcn_cvt_pk_f32_fp8((int)mr[qp + q][j], true);
                        v[q][j][0] = ALPHA * bf_lo(xv.x) + m01[0] * (1.0f / SMX8); v[q][j][1] = ALPHA * bf_hi(xv.x) + m01[1] * (1.0f / SMX8); v[q][j][2] = ALPHA * bf_lo(xv.y) + m23[0] * (1.0f / SMX8); v[q][j][3] = ALPHA * bf_hi(xv.y) + m23[1] * (1.0f / SMX8);
                        s[q] += (v[q][j][0] + v[q][j][1]) + (v[q][j][2] + v[q][j][3]); } }
                s[0] = wave_sum(s[0]); s[1] = wave_sum(s[1]);
#pragma unroll
                for (int q = 0; q < 2; ++q) { const float mean = s[q] * (1.f / D); s2[q] = 0.f;
#pragma unroll
                    for (int j = 0; j < 4; ++j) { v[q][j] = v[q][j] - mean; s2[q] += (v[q][j][0] * v[q][j][0] + v[q][j][1] * v[q][j][1]) + (v[q][j][2] * v[q][j][2] + v[q][j][3] * v[q][j][3]); } }
                s2[0] = wave_sum(s2[0]); s2[1] = wave_sum(s2[1]);
#pragma unroll
                for (int q = 0; q < 2; ++q) {
                    const int r32 = 4 * F.wave + qp + q; const size_t row = (size_t)rb * 128 + round * 32 + r32;
                    const float rstd = 1.f / sqrtf(s2[q] * (1.f / D) + LN_EPS);
#pragma unroll
                    for (int j = 0; j < 4; ++j) { const f32x4 gam = *(const LAS f32x4*)(F.lds + LC_GB + (256 * j + 4 * F.lane) * 4), bet = *(const LAS f32x4*)(F.lds + LC_GB + (D + 256 * j + 4 * F.lane) * 4); const f32x4 y = v[q][j] * rstd * gam + bet;
                        u32x2 o; o.x = cvt_pk_bf16(y[0], y[1]); o.y = cvt_pk_bf16(y[2], y[3]); *(u32x2*)(xdst + row * D + 256 * j + 4 * F.lane) = o;
                        if (!dummy) *(unsigned*)(ws + WS_XF8 + row * D + 256 * j + 4 * F.lane) = pk4_fp8(y[0] * SX8, y[1] * SX8, y[2] * SX8, y[3] * SX8);
                        *(LAS u32x2*)(Tb + r32 * 2064 + (256 * j + 4 * F.lane) * 2) = o; }
                }
            }
            if (round < 3) LN1_LOAD_ROUND(round + 1);
            __syncthreads();
            att::f32x16 acc = (att::f32x16){};
            { const LAS unsigned char* ap = Tb + jx * 2064 + (128 * F.wave + 8 * hh) * 2;
#pragma unroll
              for (int s = 0; s < 8; ++s) { const bf16x8 av = *(const LAS bf16x8*)(ap + 32 * s);
                  acc = __builtin_amdgcn_mfma_f32_32x32x16_bf16(av, bwh[s], acc, 0, 0, 0); acc = __builtin_amdgcn_mfma_f32_32x32x16_bf16(av, bwl[s], acc, 0, 0, 0); } }
            __syncthreads();
#pragma unroll
            for (int r = 0; r < 16; ++r) red[(F.wave * 32 + att::crow(r, hh)) * 32 + jx] = acc[r];
            __syncthreads();
#pragma unroll
            for (int p = 0; p < 2; ++p) { const int idx = F.tid + 512 * p, tk = idx >> 5, e = idx & 31; float s = 0.f;
#pragma unroll
                for (int w = 0; w < 8; ++w) s += red[(w * 32 + tk) * 32 + e];
                Lg[(round * 32 + tk) * 33 + e] = s; }
            __syncthreads();
        }
        __syncthreads();
        if (F.tid < 128) {
                const LAS float* lgp = Lg + F.tid * 33;
                float best = -3.0e38f; int gsel = 0; float b4[4], a4[4];
#pragma unroll
                for (int i = 0; i < 4; ++i) { b4[i] = 0.f; a4[i] = 0.f; }
#pragma unroll
                for (int g = 0; g < 8; ++g) { float af[4], bi[4];
#pragma unroll
                    for (int i = 0; i < 4; ++i) { const float lg = lgp[4 * g + i]; af[i] = 1.0f / (1.0f + __expf(-lg)); bi[i] = af[i] + ((const LAS float*)(F.lds + LC_RB))[4 * g + i]; }
                    const float h1 = fmaxf(bi[0], bi[1]), l1 = fminf(bi[0], bi[1]), h2 = fmaxf(bi[2], bi[3]), l2 = fminf(bi[2], bi[3]);
                    const float gs = fmaxf(h1, h2) + fmaxf(fminf(h1, h2), fmaxf(l1, l2));
                    const bool better = gs > best; best = better ? gs : best; gsel = better ? g : gsel;
#pragma unroll
                    for (int i = 0; i < 4; ++i) { b4[i] = better ? bi[i] : b4[i]; a4[i] = better ? af[i] : a4[i]; } }
                int i1 = 0; float m1 = b4[0];
#pragma unroll
                for (int i = 1; i < 4; ++i) { const bool gt = b4[i] > m1; m1 = gt ? b4[i] : m1; i1 = gt ? i : i1; }
                int i2 = -1; float m2 = -3.0e38f;
#pragma unroll
                for (int i = 0; i < 4; ++i) { const bool gt = (i != i1) && (b4[i] > m2); m2 = gt ? b4[i] : m2; i2 = gt ? i : i2; }
                float w1 = a4[0], w2 = a4[0];
#pragma unroll
                for (int i = 1; i < 4; ++i) { w1 = (i1 == i) ? a4[i] : w1; w2 = (i2 == i) ? a4[i] : w2; }
                const float wsum = w1 + w2;
                const int e1 = gsel * 4 + i1, e2 = gsel * 4 + i2, rloc = F.tid;
                if (dummy) { asm volatile("" :: "v"(e1), "v"(e2), "v"(wsum)); } else {
                const int r1 = __hip_atomic_fetch_add(hist + e1, 1, __ATOMIC_RELAXED, __HIP_MEMORY_SCOPE_WORKGROUP);
                const int r2 = __hip_atomic_fetch_add(hist + e2, 1, __ATOMIC_RELAXED, __HIP_MEMORY_SCOPE_WORKGROUP);
                se[2 * rloc] = e1; se[2 * rloc + 1] = e2; sr[2 * rloc] = r1; sr[2 * rloc + 1] = r2; sg[2 * rloc] = w1 / wsum; sg[2 * rloc + 1] = w2 / wsum; }
            }
        __syncthreads();
        if (F.tid < NE && !dummy) basev[F.tid] = (int)__hip_atomic_fetch_add(F.ctl + CW_CNT + 64 * l + F.tid, (unsigned)hist[F.tid], __ATOMIC_RELAXED, __HIP_MEMORY_SCOPE_AGENT);
        __syncthreads();
        if (F.tid < 256 && !dummy) { const int e = se[F.tid], rk = basev[e] + sr[F.tid]; const int t = rb * 128 + (F.tid >> 1);
            tok[(size_t)e * TOKCAP + rk] = t; slot_e[(size_t)t * 2 + (F.tid & 1)] = e; slot_r[(size_t)t * 2 + (F.tid & 1)] = rk; slot_g[(size_t)t * 2 + (F.tid & 1)] = sg[F.tid]; }
        __syncthreads();
    }
}

__device__ __forceinline__ void phase_ln2(int l, const bool dummy, const int wv) {
    PHASE_ENTRY();
    bf16_t* xdst = dummy ? merged : xb; float* fdst = dummy ? (float*)(ws + WS_YA) : xres;

            (void)moe_tables_cached(F, l);
            const LAS int* tstart = (const LAS int*)(F.lds + LC_TSTART);
            f32x4 gam[4], bet[4];
#pragma unroll
            for (int j = 0; j < 4; ++j) { gam[j] = *(const f32x4*)(ln2_g + l * D + 256 * j + 4 * F.lane); bet[j] = *(const f32x4*)(ln2_b + l * D + 256 * j + 4 * F.lane); }
            const int gw = F.bid * NWAVES + F.wave, NGW = F.G * NWAVES;
            const bool xmap = (F.G == 256); const int r_first = xmap ? 128 * F.vcu + F.wave : gw, r_pair = xmap ? 8 : NGW, r_end = xmap ? 128 * F.vcu + 128 : T;
            for (int itb = 0; r_first + 2 * r_pair * itb < r_end; itb += 16) {
            int pv; float gv;
            { const int myrow = r_first + 2 * r_pair * (itb + (F.lane >> 2)) + ((F.lane >> 1) & 1) * r_pair; const int rr = myrow < r_end ? myrow : r_first;
              const int e = slot_e[(size_t)rr * 2 + (F.lane & 1)], r = slot_r[(size_t)rr * 2 + (F.lane & 1)]; gv = slot_g[(size_t)rr * 2 + (F.lane & 1)] * (1.0f / SY28);
              pv = tstart[e] * 256 + r; }
            u32x2 xw[2][4], xn[2][4]; unsigned ya_[2][4], yb_[2][4], yan[2][4], ybn[2][4];
#define LN2_LOAD(jj_, XW, YA, YB) do { const int row0_ = r_first + 2 * r_pair * (itb + (jj_)); _Pragma("unroll") for (int q = 0; q < 2; ++q) { const int row_ = row0_ + q * r_pair; const int rr_ = row_ < r_end ? row_ : row0_; \
                    const size_t p0 = (size_t)__builtin_amdgcn_readlane(pv, 4 * (jj_) + 2 * q), p1 = (size_t)__builtin_amdgcn_readlane(pv, 4 * (jj_) + 2 * q + 1); \
                    _Pragma("unroll") for (int j = 0; j < 4; ++j) { XW[q][j] = *(const u32x2*)(xb + (size_t)rr_ * D + 256 * j + 4 * F.lane); \
                        YA[q][j] = *(const unsigned*)(ws + WS_Y2 + p0 * D + 256 * j + 4 * F.lane); YB[q][j] = *(const unsigned*)(ws + WS_Y2 + p1 * D + 256 * j + 4 * F.lane); } } } while (0)
            LN2_LOAD(0, xw, ya_, yb_);
            for (int jj = 0; jj < 16; ++jj) { const int row0 = r_first + 2 * r_pair * (itb + jj); if (row0 >= r_end) break;
                const bool more = (jj + 1 < 16) && (row0 + 2 * r_pair < r_end);
                if (more) LN2_LOAD(jj + 1, xn, yan, ybn);
                float g0[2], g1[2]; bool ok[2];
#pragma unroll
                for (int q = 0; q < 2; ++q) { const int row = row0 + q * r_pair; ok[q] = row < r_end;
                    g0[q] = __uint_as_float(__builtin_amdgcn_readlane(__float_as_uint(gv), 4 * jj + 2 * q)); g1[q] = __uint_as_float(__builtin_amdgcn_readlane(__float_as_uint(gv), 4 * jj + 2 * q + 1)); }
                f32x4 v[2][4]; float s[2], s2[2];
#pragma unroll
                for (int q = 0; q < 2; ++q) { s[q] = 0.f;
#pragma unroll
                    for (int j = 0; j < 4; ++j) { const u32x2 x_ = xw[q][j];
                        const f32x2 a01 = __builtin_amdgcn_cvt_pk_f32_fp8((int)ya_[q][j], false), a23 = __builtin_amdgcn_cvt_pk_f32_fp8((int)ya_[q][j], true), b01 = __builtin_amdgcn_cvt_pk_f32_fp8((int)yb_[q][j], false), b23 = __builtin_amdgcn_cvt_pk_f32_fp8((int)yb_[q][j], true);
                        v[q][j][0] = ALPHA * bf_lo(x_.x) + (g0[q] * a01[0] + g1[q] * b01[0]); v[q][j][1] = ALPHA * bf_hi(x_.x) + (g0[q] * a01[1] + g1[q] * b01[1]);
                        v[q][j][2] = ALPHA * bf_lo(x_.y) + (g0[q] * a23[0] + g1[q] * b23[0]); v[q][j][3] = ALPHA * bf_hi(x_.y) + (g0[q] * a23[1] + g1[q] * b23[1]);
                        s[q] += (v[q][j][0] + v[q][j][1]) + (v[q][j][2] + v[q][j][3]); } }
                s[0] = wave_sum(s[0]); s[1] = wave_sum(s[1]);
#pragma unroll
                for (int q = 0; q < 2; ++q) { const float mean = s[q] * (1.f / D); s2[q] = 0.f;
#pragma unroll
                    for (int j = 0; j < 4; ++j) { v[q][j] = v[q][j] - mean; s2[q] += (v[q][j][0] * v[q][j][0] + v[q][j][1] * v[q][j][1]) + (v[q][j][2] * v[q][j][2] + v[q][j][3] * v[q][j][3]); } }
                s2[0] = wave_sum(s2[0]); s2[1] = wave_sum(s2[1]);
#pragma unroll
                for (int q = 0; q < 2; ++q) { if (!ok[q]) continue; const int row = row0 + q * r_pair;
                    const float rstd = 1.f / sqrtf(s2[q] * (1.f / D) + LN_EPS);
#pragma unroll
                    for (int j = 0; j < 4; ++j) { const f32x4 y = v[q][j] * rstd * gam[j] + bet[j];
                        if (l == DEPTH - 1) *(f32x4*)(fdst + (size_t)row * D + 256 * j + 4 * F.lane) = y;
                        else { u32x2 o; o.x = cvt_pk_bf16(y[0], y[1]); o.y = cvt_pk_bf16(y[2], y[3]); *(u32x2*)(xdst + (size_t)row * D + 256 * j + 4 * F.lane) = o;
                            if (!dummy) *(unsigned*)(ws + WS_XF8 + (size_t)row * D + 256 * j + 4 * F.lane) = pk4_fp8(y[0] * SX8, y[1] * SX8, y[2] * SX8, y[3] * SX8); } } }
                if (more) {
#pragma unroll
                    for (int q = 0; q < 2; ++q)
#pragma unroll
                        for (int j = 0; j < 4; ++j) { xw[q][j] = xn[q][j]; ya_[q][j] = yan[q][j]; yb_[q][j] = ybn[q][j]; } }
            }
#undef LN2_LOAD
            }
        }

__device__ __forceinline__ void xcd_barrier_work(const int wv, const bool want_local, const bool work) {
    const int tid_ = wv * 64 + lane_now();
    asm volatile("s_waitcnt vmcnt(0)" ::: "memory");
    __syncthreads();
    volatile LAS int* misc = (volatile LAS int*)((LAS unsigned char*)lds_raw + LC_MISC);
    XcdBarrier b; { kargp_t kq = (kargp_t)__builtin_amdgcn_kernarg_segment_ptr(); asm volatile("" : "+s"(kq)); b.bar = (unsigned*)(kq->ws + WS_CTL) + CW_BAR; b.x = xb_xcc_id(); b.st = (volatile LAS unsigned*)((LAS unsigned char*)lds_raw + LC_MISC) + 8; }
    const unsigned gen_expected = (unsigned)misc[LW_GEN] + 1u;
    __syncthreads();
    if (tid_ < 64) {
        if (tid_ == 0) {
            unsigned* bar = b.bar;
            __builtin_amdgcn_s_waitcnt(0);
            unsigned nloc = b.st[0], nx = b.st[1];
            if (nloc == 0u) { xcd_barrier_complete(bar, b.x, nloc, nx); b.st[0] = nloc; b.st[1] = nx;
                unsigned seen = 0u, okc = (gridDim.x == 256u) ? 1u : 0u;
#pragma unroll
                for (int c = 0; c < 8; ++c) { const unsigned m = xb_ld(&bar[CW_CLS - CW_BAR + c]); okc &= (m != 0u && (m & (m - 1u)) == 0u && (seen & m) == 0u) ? 1u : 0u; seen |= m; }
                b.st[2] = 1u + okc; }
            const bool local = want_local && (b.st[2] == 2u);
            if (local) {
                const unsigned lc = b.st[3] + 1u; b.st[3] = lc;
                (void)__hip_atomic_fetch_add(&bar[XB_XLOC(b.x)], 1u, __ATOMIC_RELAXED, __HIP_MEMORY_SCOPE_AGENT);
                asm volatile("buffer_inv sc1" ::: "memory");
                XB_SPIN(xb_ld(&bar[XB_XLOC(b.x)]) < lc * nloc, bar);
                asm volatile("s_waitcnt vmcnt(0)" ::: "memory");
            } else {
            const unsigned old = xb_add(&bar[XB_XSUB(b.x)], 1u);
            asm volatile("buffer_inv sc1" ::: "memory");
            const unsigned gen = old / nloc;
            if (old + 1u == (gen + 1u) * nloc) {
                __builtin_amdgcn_fence(__ATOMIC_RELEASE, "agent");
                asm volatile("s_waitcnt vmcnt(0)" ::: "memory");
                (void)__hip_atomic_fetch_add(&bar[XB_TOP], 1u, __ATOMIC_RELAXED, __HIP_MEMORY_SCOPE_AGENT);
            }
            XB_SPIN(xb_ld(&bar[XB_TOP]) < (gen + 1u) * nx, bar);
            asm volatile("s_waitcnt vmcnt(0)" ::: "memory");
            }
            misc[LW_REL] = (int)gen_expected;
        }
    } else {
        kargp_t kp = (kargp_t)__builtin_amdgcn_kernarg_segment_ptr(); asm volatile("" : "+s"(kp)); unsigned char* ws = kp->ws;
        const int lane = lane_now(), wave = wv;
        LAS float* scr = (LAS float*)((LAS unsigned char*)lds_raw + wave * 16384);
        bool more = (NREP(16) > 1) ? false : work;
        while (misc[LW_REL] != (int)gen_expected) {
            if (more) more = cq_step(kp, ws, scr, lane, QTOTAL);
            else __builtin_amdgcn_s_sleep(4);
        }
    }
    __syncthreads();
    if (tid_ == 0) misc[LW_GEN] = (int)gen_expected;
}
__device__ __forceinline__ void cq_drain(kargp_t kp, unsigned char* ws, int lmax, const int wv) {
    const int lane = lane_now(), wave = wv;
    LAS float* scr = (LAS float*)((LAS unsigned char*)lds_raw + wave * 16384);
    __syncthreads();
    while (cq_step(kp, ws, scr, lane, lmax * NPL)) {}
    __syncthreads();
}


__global__ void __launch_bounds__(NTHREADS, 2) fwd_kernel(Args args) {
    Frame F;
    F.lds = (LAS unsigned char*)lds_raw;
    const int wv0 = __builtin_amdgcn_readfirstlane(threadIdx.x >> 6);
    F.wave = wv0; F.lane = lane_now(); F.tid = wv0 * 64 + F.lane;
    F.G = gridDim.x; { const int bx = blockIdx.x; F.bid = bx; F.vcu = (F.G % 8 == 0) ? (bx % 8) * (F.G / 8) + bx / 8 : bx; }
    unsigned char* ws = args.ws;
    F.ctl = (gu32*)(ws + WS_CTL);
    for (int u = F.tid; u < (LDS_BYTES - LC_OFF) / 4; u += NTHREADS) ((LAS unsigned*)(F.lds + LC_OFF))[u] = 0u;
    __syncthreads();
    if (F.tid == 0) ((LAS int*)(F.lds + LC_MISC))[LW_Q] = QB;
    __syncthreads();
#if MK_ONE_LAUNCH
    if (F.tid == 0) { (void)__hip_atomic_fetch_or(F.ctl + CW_CLS + (F.bid & 7), 1u << xb_xcc_id(), __ATOMIC_RELAXED, __HIP_MEMORY_SCOPE_AGENT); asm volatile("s_waitcnt vmcnt(0)" ::: "memory"); }
    (void)xcd_barrier_post((unsigned*)(F.ctl + CW_BAR), (volatile LAS unsigned*)(F.lds + LC_MISC) + 8);
#define GRID_BAR() xcd_barrier_work(wv0, false, true)
#define XCD_BAR() xcd_barrier_work(wv0, true, true)
#define XCD_BAR_NW() xcd_barrier_work(wv0, true, false)
#else
#define GRID_BAR() do {} while (0)
#define XCD_BAR() do {} while (0)
#define XCD_BAR_NW() do {} while (0)
#endif
    kargp_t kp = (kargp_t)__builtin_amdgcn_kernarg_segment_ptr();
    const int lo = args.ph_lo, hi = args.ph_hi; (void)ws;
#ifndef PH_MASK
#define PH_MASK 0x1ff
#endif
#define IN(k) (lo <= (k) && (k) < hi)
#define EN(p) ((PH_MASK >> (p)) & 1)

#define FRESH() do { F.wave = wv0; F.lane = lane_now(); F.tid = wv0 * 64 + F.lane; { int bx_ = blockIdx.x; asm volatile("" : "+s"(bx_)); F.bid = bx_; } \
        kp = (kargp_t)__builtin_amdgcn_kernarg_segment_ptr(); asm volatile("" : "+s"(kp)); ws = kp->ws; F.ctl = (gu32*)(ws + WS_CTL); } while (0)
#define SEAM(k) do { if (IN(k) && IN((k) + 1)) GRID_BAR(); } while (0)
#define SEAM_LN(k) do { if (IN(k) && IN((k) + 1)) XCD_BAR_NW(); } while (0)
#define SEAM_L(k) do { if (IN(k) && IN((k) + 1)) XCD_BAR(); } while (0)

    if (EN(8) && IN(0)) for (int rep_ = 0; rep_ < NREP(8); ++rep_) { phase_prologue(wv0); }
    SEAM(0);

    for (int l = 0; l < DEPTH; ++l) {
        const int pb = 1 + 8 * l;
        if (EN(0) && IN(pb + 0)) for (int rep_ = 0; rep_ < (NREP(0) > NREP(11) ? NREP(0) : NREP(11)); ++rep_) { FRESH();
            pg8::SchedStatic S{(const char*)(ws + WS_XF8), (const char*)(ws + WS_WIN) + (size_t)l * NIN * D, T / 256, NIN / 256, F.G, F.bid, (size_t)256 * D};
            pg8::EpiProj E{proj, bias_s + l * NIN, (NREP(11) > 1 && rep_ == 0) ? 1 : 0, (unsigned char*)(ws + WS_GATE)};
            pg8::gemm_phase<D / 2, false, pg8::EpiProj, pg8::SchedStatic, false, true>(F.lds, F.tid, S, E, E_X8, E_W8);
        }
        SEAM_L(pb + 0);
        if (EN(1) && IN(pb + 1)) for (int rep_ = 0; rep_ < NREP(1); ++rep_) {
            phase_attn_mfma(l, wv0);
        }
        SEAM_LN(pb + 1);
        if (EN(2) && IN(pb + 2)) for (int rep_ = 0; rep_ < (NREP(2) > NREP(12) ? NREP(2) : NREP(12)); ++rep_) { FRESH();
            pg8::SchedTwoSeg S{(const char*)(ws + WS_YA), (long)(16 * MiB), (const char*)(ws + WS_WA) + (size_t)l * D * 512, (long)(WS_WB - WS_WA), T / 256, D / 256, F.G, F.bid, (size_t)256 * 512};
            pg8::EpiMerge E{(unsigned char*)(ws + WS_MERGED), (const unsigned char*)(ws + WS_GATE), (NREP(12) > 1 && rep_ == 0) ? 1 : 0};
            pg8::gemm_phase<D / 2, false, pg8::EpiMerge, pg8::SchedTwoSeg, true, true>(F.lds, F.tid, S, E, E_Y8, E_W8);
        }
        SEAM_LN(pb + 2);
        if (EN(3) && IN(pb + 3)) for (int rep_ = 0; rep_ < NREP(3); ++rep_) { FRESH();
            pg8::SchedStatic S{(const char*)(ws + WS_MERGED), (const char*)(ws + WS_WO) + (size_t)l * D * D, T / 256, D / 256, F.G, F.bid, (size_t)256 * D};
            pg8::EpiPlain8 E{(unsigned char*)mix, D, SMX8};
            pg8::gemm_phase<D / 2, false, pg8::EpiPlain8, pg8::SchedStatic, false, true>(F.lds, F.tid, S, E, E_M8, E_W8);
        }
        SEAM_LN(pb + 3);
        if (EN(4) && IN(pb + 4)) { phase_ln1(l, false, wv0); }
        SEAM(pb + 4);
        if (EN(5) && IN(pb + 5)) for (int rep_ = 0; rep_ < NREP(5); ++rep_) { FRESH();
            const int ntiles = moe_tables(F, l);
            pg8::SchedMoe S{(const char*)(ws + WS_XF8), (const char*)(ws + WS_WGU) + (size_t)l * NE * 1024 * D, tok, (const LAS int*)(F.lds + LC_T2E), (const LAS int*)(F.lds + LC_TSTART), (const LAS int*)(F.lds + LC_CNT), ntiles, F.G, F.vcu,
                            0, (size_t)1024 * D, (size_t)256 * D, D};
            pg8::EpiSwiglu E{(unsigned char*)(ws + WS_H)};
            pg8::gemm_phase<D / 2, true, pg8::EpiSwiglu, pg8::SchedMoe, false, true>(F.lds, F.tid, S, E, E_X8, E_W8);
        }
        SEAM_LN(pb + 5);
        if (EN(6) && IN(pb + 6)) for (int rep_ = 0; rep_ < NREP(6); ++rep_) { FRESH();
            const int ntiles = moe_tables_cached(F, l);
            pg8::SchedMoe S{(const char*)(ws + WS_H), (const char*)(ws + WS_WD) + (size_t)l * NE * D * DE, tok, (const LAS int*)(F.lds + LC_T2E), (const LAS int*)(F.lds + LC_TSTART), (const LAS int*)(F.lds + LC_CNT), ntiles, F.G, F.vcu,
                            (size_t)256 * DE, (size_t)D * DE, (size_t)256 * DE, DE};
            pg8::EpiPlain8 E{(unsigned char*)(ws + WS_Y2), D, SY28};
            pg8::gemm_phase<DE / 2, false, pg8::EpiPlain8, pg8::SchedMoe, false, true>(F.lds, F.tid, S, E, E_H8, E_W8);
        }
#if MK_ONE_LAUNCH
        if (EN(6) && IN(pb + 6) && l + 1 < DEPTH) { FRESH(); cq_drain(kp, ws, l + 1, wv0); }
#endif
        SEAM(pb + 6);
        if (EN(7) && IN(pb + 7)) { phase_ln2(l, false, wv0); }
        SEAM_LN(pb + 7);
    }
#undef IN
#undef SEAM
}


extern "C" void kernel_launch(void* const* d_in, const int* in_sizes, int n_in, void* d_out, int out_size, void* d_ws, size_t ws_size, hipStream_t stream) {
    static int grid = 0;
    if (grid == 0) {
        if (n_in != 16 || in_sizes[0] != T * D || out_size != T * D || ws_size < WS_END) { fprintf(stderr, "kernel_launch: unexpected shapes (n_in %d, in0 %d, out %d, ws %zu < %zu)\n", n_in, n_in > 0 ? in_sizes[0] : -1, out_size, ws_size, (size_t)WS_END); grid = -1; return; }
        int dev = 0, cus = 0, per_cu = 0;
        if (hipGetDevice(&dev) != hipSuccess || hipDeviceGetAttribute(&cus, hipDeviceAttributeMultiprocessorCount, dev) != hipSuccess) { grid = -1; return; }
        if (hipFuncSetAttribute((const void*)fwd_kernel, hipFuncAttributeMaxDynamicSharedMemorySize, LDS_BYTES) != hipSuccess) { fprintf(stderr, "kernel_launch: hipFuncSetAttribute failed\n"); grid = -1; return; }
        if (hipOccupancyMaxActiveBlocksPerMultiprocessor(&per_cu, (const void*)fwd_kernel, NTHREADS, LDS_BYTES) != hipSuccess || per_cu < 1) fprintf(stderr, "kernel_launch: occupancy query reports %d\n", per_cu);
        (void)hipGetLastError();
        grid = cus;
    }
    if (grid < 0) return;
    (void)hipMemsetAsync((char*)d_ws + WS_CTL, 0, CTL_ZERO_BYTES, stream);
    Args a{};
    for (int i = 0; i < 16; ++i) a.in[i] = (const float*)d_in[i];
    a.out = (float*)d_out; a.ws = (unsigned char*)d_ws;
#if MK_ONE_LAUNCH
    a.ph_lo = 0; a.ph_hi = N_PHASES;
    hipLaunchKernelGGL(fwd_kernel, dim3(grid), dim3(NTHREADS), LDS_BYTES, stream, a);
#else
    for (int p = 0; p < N_PHASES; ++p) { a.ph_lo = p; a.ph_hi = p + 1; hipLaunchKernelGGL(fwd_kernel, dim3(grid), dim3(NTHREADS), LDS_BYTES, stream, a);
    }
#endif
}
```
